# Optimizing an MI355X kernel written in HIP

```python
import math
import jax, jax.numpy as jnp
from jax import lax
import numpy as np

D_MODEL = 1024
BATCH = 16
SEQ = 2048
DEPTH = 1

CTX_LEN = 256
GRID_W = 64
RET_HEADS = 4
RET_DK = 64
RET_DV = 128
RET_CHUNK = 128
MLA_HEADS = 4
MLA_NOPE = 128
MLA_ROPE = 64
MLA_V = 128
Q_LORA = 384
KV_LORA = 256
D_MIX = RET_HEADS * RET_DV + MLA_HEADS * MLA_V
D_FF = 4 * D_MODEL
ROPE_BASE = 10000.0
Q_BLOCK = 128
EPS = 1e-6
IN_SPLITS = (RET_HEADS * RET_DK, RET_HEADS * RET_DK, RET_HEADS * RET_DV, RET_HEADS * RET_DV,
             Q_LORA, KV_LORA, MLA_ROPE)
IN_COLS = sum(IN_SPLITS)
SPLIT_POINTS = tuple(int(v) for v in np.cumsum(IN_SPLITS)[:-1])

kernel_name = "hymba_retention_mla_adaln_prefix_block"


def rms_norm(x, g):
    x32 = x.astype(jnp.float32)
    y = x32 * lax.rsqrt(jnp.mean(x32 * x32, axis=-1, keepdims=True) + EPS)
    return (y * g.astype(jnp.float32)).astype(x.dtype)


def modulate(h, shift, scale):
    return h * (1 + scale) + shift


def axial_rope_tables(rows, dim):
    row = jnp.repeat(jnp.arange(rows, dtype=jnp.float32), GRID_W)
    col = jnp.tile(jnp.arange(GRID_W, dtype=jnp.float32), rows)
    n_freq = dim // 4
    freq = ROPE_BASE ** (-jnp.arange(n_freq, dtype=jnp.float32) / n_freq)
    ang = jnp.concatenate([row[:, None] * freq, col[:, None] * freq], axis=-1)
    return jnp.cos(ang)[:, None, :], jnp.sin(ang)[:, None, :]


def apply_rope(x, cos, sin):
    half = x.shape[-1] // 2
    x1, x2 = x[..., :half], x[..., half:]
    return jnp.concatenate([x1 * cos - x2 * sin, x2 * cos + x1 * sin], axis=-1).astype(x.dtype)


def retention_chunked(q, k, v, log_gamma, s0):
    B, L, H, dk = q.shape
    dv = v.shape[-1]
    n = L // RET_CHUNK
    qc = q.reshape(B, n, RET_CHUNK, H, dk)
    kc = k.reshape(B, n, RET_CHUNK, H, dk)
    vc = v.reshape(B, n, RET_CHUNK, H, dv)
    pos = jnp.arange(RET_CHUNK, dtype=jnp.float32)
    diff = pos[:, None] - pos[None, :]
    dec = jnp.where(diff >= 0, jnp.exp(log_gamma[:, None, None] * jnp.maximum(diff, 0.0)), 0.0)
    scores = jnp.einsum('bnihd,bnjhd->bnhij', qc, kc) * dec
    o_intra = jnp.einsum('bnhij,bnjhe->bnihe', scores, vc)
    w_k = jnp.exp(log_gamma[:, None] * (RET_CHUNK - 1 - pos)[None, :])
    kv = jnp.einsum('bnjhd,hj,bnjhe->bnhde', kc, w_k, vc).astype(jnp.float32)
    chunk_decay = jnp.exp(log_gamma * RET_CHUNK)[:, None, None]

    def step(s, kv_n):
        return chunk_decay * s + kv_n, s

    _, s_prev = lax.scan(step, s0.astype(jnp.float32), jnp.moveaxis(kv, 1, 0))
    w_q = jnp.exp(log_gamma[:, None] * (pos + 1.0)[None, :])
    o_cross = jnp.einsum('bnihd,hi,nbhde->bnihe', qc, w_q, s_prev)
    return (o_intra + o_cross).reshape(B, L, H, dv)


def retention_final_state(k, v, log_gamma):
    L = k.shape[1]
    w = jnp.exp(log_gamma[:, None] * (L - 1 - jnp.arange(L, dtype=jnp.float32))[None, :])
    return jnp.einsum('blhd,hl,blhe->bhde', k, w, v).astype(jnp.float32)


def retention_mix(q, k, v, gate, lg_f, lg_b, g_ret, s_f, s_b):
    B, L, H, dv = v.shape
    o_f = retention_chunked(q, k, v, lg_f, s_f)
    o_b = retention_chunked(q[:, ::-1], k[:, ::-1], v[:, ::-1], lg_b, s_b)[:, ::-1]
    o = (o_f + o_b).astype(jnp.float32)
    mu = jnp.mean(o, axis=-1, keepdims=True)
    var = jnp.mean(jnp.square(o - mu), axis=-1, keepdims=True)
    o = (o - mu) * lax.rsqrt(var + EPS) * g_ret.astype(jnp.float32).reshape(H, dv)
    return (o.reshape(B, L, H * dv) * jax.nn.silu(gate.astype(jnp.float32))).astype(gate.dtype)


def attend(q, k, v):
    s = jnp.einsum('bqhd,bkhd->bhqk', q, k).astype(jnp.float32) * (1.0 / math.sqrt(q.shape[-1]))
    p = jax.nn.softmax(s, axis=-1)
    return jnp.einsum('bhqk,bkhe->bqhe', p.astype(v.dtype), v)


def blocked_attention(q, k, v):
    B, L, H, d = q.shape
    qb = q.reshape(B, L // Q_BLOCK, Q_BLOCK, H, d).swapaxes(0, 1)
    out = lax.map(lambda qi: attend(qi, k, v), qb)
    return out.swapaxes(0, 1).reshape(B, L, H, v.shape[-1])


def head_group_inputs(h, w_in, g_q, w_uq, g_kv, w_ukv):
    B, L, _ = h.shape
    r_q, r_k, r_v, r_g, c_q, c_kv, k_pe = jnp.split(h @ w_in, SPLIT_POINTS, axis=-1)
    r_q = r_q.reshape(B, L, RET_HEADS, RET_DK)
    r_k = r_k.reshape(B, L, RET_HEADS, RET_DK) * (RET_DK ** -0.5)
    r_v = r_v.reshape(B, L, RET_HEADS, RET_DV)
    q = (rms_norm(c_q, g_q) @ w_uq).reshape(B, L, MLA_HEADS, MLA_NOPE + MLA_ROPE)
    kv = (rms_norm(c_kv, g_kv) @ w_ukv).reshape(B, L, MLA_HEADS, MLA_NOPE + MLA_V)
    q_nope, q_pe = q[..., :MLA_NOPE], q[..., MLA_NOPE:]
    k_nope, m_v = kv[..., :MLA_NOPE], kv[..., MLA_NOPE:]
    k_pe = k_pe[:, :, None, :]
    return r_q, r_k, r_v, r_g, q_nope, q_pe, k_nope, k_pe, m_v


def mla_qk(q_nope, q_pe, k_nope, k_pe):
    q = jnp.concatenate([q_nope, q_pe], axis=-1)
    k = jnp.concatenate([k_nope, jnp.broadcast_to(k_pe, k_nope.shape[:-1] + (MLA_ROPE,))], axis=-1)
    return q, k


def sq_relu_mlp(h, w1, w2):
    return jnp.square(jax.nn.relu(h @ w1)) @ w2


def setup_inputs(seed: int = 0) -> dict:
    key = jax.random.key(seed)
    ks = jax.random.split(key, 24)
    f32 = jnp.float32

    def nrm(k, shape, scale):
        return jax.random.normal(k, shape, f32) * scale

    base_logit = jnp.log(2.0 ** (5.0 + jnp.arange(RET_HEADS, dtype=f32)) - 1.0)
    return {
        "x": nrm(ks[0], (BATCH, SEQ, D_MODEL), 1.0),
        "c": nrm(ks[1], (BATCH, D_MODEL), 1.0),
        "ctx": nrm(ks[2], (BATCH, CTX_LEN, D_MODEL), 1.0),
        "c_ctx": nrm(ks[3], (D_MODEL,), 1.0),
        "w_ada": nrm(ks[4], (DEPTH, D_MODEL, 6 * D_MODEL), 0.5 * D_MODEL ** -0.5),
        "b_ada": nrm(ks[5], (DEPTH, 6 * D_MODEL), 0.01),
        "g_attn": 1.0 + nrm(ks[6], (DEPTH, D_MODEL), 0.05),
        "g_ffn": 1.0 + nrm(ks[7], (DEPTH, D_MODEL), 0.05),
        "w_in": nrm(ks[8], (DEPTH, D_MODEL, IN_COLS), D_MODEL ** -0.5),
        "ret_decay_fwd": base_logit + nrm(ks[9], (DEPTH, RET_HEADS), 0.1),
        "ret_decay_bwd": base_logit + nrm(ks[10], (DEPTH, RET_HEADS), 0.1),
        "g_ret": 1.0 + nrm(ks[11], (DEPTH, RET_HEADS * RET_DV), 0.05),
        "g_q_lora": 1.0 + nrm(ks[12], (DEPTH, Q_LORA), 0.05),
        "w_uq": nrm(ks[13], (DEPTH, Q_LORA, MLA_HEADS * (MLA_NOPE + MLA_ROPE)), Q_LORA ** -0.5),
        "g_kv_lora": 1.0 + nrm(ks[14], (DEPTH, KV_LORA), 0.05),
        "w_ukv": nrm(ks[15], (DEPTH, KV_LORA, MLA_HEADS * (MLA_NOPE + MLA_V)), KV_LORA ** -0.5),
        "w_out": nrm(ks[16], (DEPTH, D_MIX, D_MODEL), D_MIX ** -0.5),
        "w_ff1": nrm(ks[17], (DEPTH, D_MODEL, D_FF), D_MODEL ** -0.5),
        "w_ff2": nrm(ks[18], (DEPTH, D_FF, D_MODEL), D_FF ** -0.5),
        "g_final": 1.0 + nrm(ks[19], (D_MODEL,), 0.05),
    }


def reference(x, c, ctx, c_ctx, w_ada, b_ada, g_attn, g_ffn, w_in, ret_decay_fwd, ret_decay_bwd,
              g_ret, g_q_lora, w_uq, g_kv_lora, w_ukv, w_out, w_ff1, w_ff2, g_final):
    B, L, _ = x.shape
    rows = L // GRID_W
    cos, sin = axial_rope_tables(rows, RET_DK)
    for l in range(DEPTH):
        mod = jax.nn.silu(c) @ w_ada[l] + b_ada[l]
        mod_c = jax.nn.silu(c_ctx) @ w_ada[l] + b_ada[l]
        sh_a, sc_a, gt_a, sh_f, sc_f, gt_f = [m[:, None, :] for m in jnp.split(mod, 6, axis=-1)]
        csh_a, csc_a, cgt_a, csh_f, csc_f, cgt_f = jnp.split(mod_c, 6, axis=-1)

        h = modulate(rms_norm(x, g_attn[l]), sh_a, sc_a)
        hc = modulate(rms_norm(ctx, g_attn[l]), csh_a, csc_a)
        rq, rk, rv, rg, qn, qp, kn, kp, mv = head_group_inputs(h, w_in[l], g_q_lora[l], w_uq[l],
                                                                g_kv_lora[l], w_ukv[l])
        rqc, rkc, rvc, rgc, qnc, qpc, knc, kpc, mvc = head_group_inputs(hc, w_in[l], g_q_lora[l], w_uq[l],
                                                                        g_kv_lora[l], w_ukv[l])
        rq, rk = apply_rope(rq, cos, sin), apply_rope(rk, cos, sin)
        qp, kp = apply_rope(qp, cos, sin), apply_rope(kp, cos, sin)

        lg_f = jax.nn.log_sigmoid(ret_decay_fwd[l].astype(jnp.float32))
        lg_b = jax.nn.log_sigmoid(ret_decay_bwd[l].astype(jnp.float32))
        s_f = retention_final_state(rkc, rvc, lg_f)
        s_b = retention_final_state(rkc[:, ::-1], rvc[:, ::-1], lg_b)
        y_ret = retention_mix(rq, rk, rv, rg, lg_f, lg_b, g_ret[l], s_f, s_b)

        q_m, k_m = mla_qk(qn, qp, kn, kp)
        q_mc, k_mc = mla_qk(qnc, qpc, knc, kpc)
        y_mla = blocked_attention(q_m, jnp.concatenate([k_mc, k_m], axis=1),
                                  jnp.concatenate([mvc, mv], axis=1)).reshape(B, L, MLA_HEADS * MLA_V)

        x_mid = x + gt_a * (jnp.concatenate([y_ret, y_mla], axis=-1) @ w_out[l])

        if l + 1 < DEPTH:
            zero_state = jnp.zeros((B, RET_HEADS, RET_DK, RET_DV), jnp.float32)
            y_ret_c = retention_mix(rqc, rkc, rvc, rgc, lg_f, lg_b, g_ret[l], zero_state, zero_state)
            y_mla_c = attend(q_mc, k_mc, mvc).reshape(B, CTX_LEN, MLA_HEADS * MLA_V)
            ctx = ctx + cgt_a * (jnp.concatenate([y_ret_c, y_mla_c], axis=-1) @ w_out[l])
            ctx = ctx + cgt_f * sq_relu_mlp(modulate(rms_norm(ctx, g_ffn[l]), csh_f, csc_f),
                                            w_ff1[l], w_ff2[l])

        x = x_mid + gt_f * sq_relu_mlp(modulate(rms_norm(x_mid, g_ffn[l]), sh_f, sc_f),
                                       w_ff1[l], w_ff2[l])
    return rms_norm(x, g_final)
```

```cpp
#include <hip/hip_runtime.h>
#include <hip/hip_bf16.h>
#include <hip/hip_cooperative_groups.h>
#include <cstdio>
#include <cstdint>
namespace cg = cooperative_groups;

constexpr int DM = 1024, NB = 16, SEQ = 2048, CTXL = 256, TOK = SEQ + CTXL, MALL = NB * TOK, MLAT = NB * SEQ;
constexpr int NIN = 2240, NINP = 2304, DFF = 4096, QL = 384, KVL = 256, NQ = 768, NKV = 1024;
constexpr float EPS = 1e-6f;
constexpr int C_RQ = 0, C_RK = 256, C_RV = 512, C_RG = 1024, C_CQ = 1536, C_CKV = 1920, C_KPE = 2176;
constexpr size_t MiB = 1u << 20;
constexpr size_t WS_MOD = 0, WS_ROPE = MiB / 2, WS_WIN = 1 * MiB, WS_WUQ = 6 * MiB, WS_WUKV = 7 * MiB, WS_WOUT = 8 * MiB, WS_W1 = 10 * MiB, WS_W2 = 18 * MiB;
constexpr size_t WS_SSQ = 26 * MiB, WS_ST = 34 * MiB, WS_HN = 66 * MiB, WS_P = 138 * MiB, WS_Q = 300 * MiB, WS_KV = 354 * MiB, WS_END = 426 * MiB;
constexpr size_t WS_HID = WS_P;
static_assert(WS_P + (size_t)MALL * NINP * 2 <= WS_Q && WS_Q + (size_t)MALL * NQ * 2 <= WS_KV && WS_KV + (size_t)MALL * NKV * 2 <= WS_END && WS_HID + (size_t)MLAT * DFF * 2 <= WS_END, "ws map");
static_assert(WS_HN + (size_t)MALL * DM * 2 <= WS_P && WS_ST + (size_t)NB * 4 * 16 * 128 * 128 * 2 <= WS_HN && WS_SSQ + (size_t)MALL * 24 * 4 <= WS_ST, "ws map 2");
constexpr int LDS_BYTES = 147456;

#ifndef ATT_SDEPTH
#define ATT_SDEPTH 1
#endif
#ifndef ATT_NQREG
#define ATT_NQREG 12
#endif
namespace pg8 {
#define PG8_LAS __attribute__((address_space(3)))
typedef unsigned short bf16_t;
typedef short bf16x8 __attribute__((ext_vector_type(8)));
typedef float f32x4 __attribute__((ext_vector_type(4)));
typedef unsigned u32x4 __attribute__((ext_vector_type(4)));
constexpr int BM = 256, BK = 64, HALF = 128, HTB = HALF * BK * 2  , STAGE_BYTES = 8 * HTB, NXCD = 8, WGM = 8;

__host__ __device__ __forceinline__ int lds_byte(int r, int c) { const int st = (r >> 4) * 2 + (c >> 5), rr = r & 15, cc = c & 31, ob = rr * 64 + cc * 2; return st * 1024 + (ob ^ (((ob >> 9) & 1) << 5)); }
__host__ __device__ __forceinline__ void stage_rc(int b, int& R, int& C) { const int st = b / 1024, sb = b % 1024, swz = sb ^ (((sb >> 9) & 1) << 5); R = (st >> 1) * 16 + swz / 64; C = (st & 1) * 32 + (swz % 64) / 2; }
__host__ __device__ __forceinline__ int perm32(int rho) { const int n = rho >> 4, i = rho & 15; return 8 * (i >> 2) + 4 * n + (i & 3); }

struct Unit { int pm, pn; };
struct Gemm { const bf16_t* A; const bf16_t* Bt; int M, N, K, lda; };

struct StaticOrder {
    int nM, nN, nwg, G, c;
    __host__ __device__ void init(int M, int N, int G_, int c_) { nM = M / BM; nN = N / BM; nwg = nM * nN; G = G_; c = c_; }
    __host__ __device__ bool next(int i, Unit& u) const {
        const long L = (long)i * G + c; if (L >= nwg) return false;
        int wgid = (int)L; { const int q = nwg / NXCD, r = nwg % NXCD, xcd = wgid % NXCD, off = wgid / NXCD; wgid = (xcd < r ? xcd * (q + 1) : r * (q + 1) + (xcd - r) * q) + off; }
        const int nig = WGM * nN, gid = wgid / nig, fm = gid * WGM, gsz = (nM - fm) < WGM ? (nM - fm) : WGM;
        u.pm = fm + ((wgid % nig) % gsz); u.pn = (wgid % nig) / gsz; return true;
    }
    __device__ __forceinline__ void a_ready(const Unit&) const {}
    __device__ __forceinline__ void done(const Unit&) const {}
};

__device__ __forceinline__ unsigned cvt_pk_bf16(float lo, float hi) { unsigned r; asm volatile("v_cvt_pk_bf16_f32 %0, %1, %2" : "=v"(r) : "v"(lo), "v"(hi)); return r; }
typedef float f32x2 __attribute__((ext_vector_type(2)));
__device__ __forceinline__ void store8(bf16_t* p, const f32x4 v0, const f32x4 v1) {
    u32x4 w; w.x = cvt_pk_bf16(v0[0], v0[1]); w.y = cvt_pk_bf16(v0[2], v0[3]); w.z = cvt_pk_bf16(v1[0], v1[1]); w.w = cvt_pk_bf16(v1[2], v1[3]); *(u32x4*)p = w;
}
__device__ __forceinline__ void rope8(f32x4& v0, f32x4& v1, const float* cs) {
    const f32x4 a = *(const f32x4*)cs, b = *(const f32x4*)(cs + 4); f32x4 o0, o1;
    o0[0] = v0[0] * a[0] - v0[1] * a[1]; o0[1] = v0[1] * a[0] + v0[0] * a[1]; o0[2] = v0[2] * a[2] - v0[3] * a[3]; o0[3] = v0[3] * a[2] + v0[2] * a[3];
    o1[0] = v1[0] * b[0] - v1[1] * b[1]; o1[1] = v1[1] * b[0] + v1[0] * b[1]; o1[2] = v1[2] * b[2] - v1[3] * b[3]; o1[3] = v1[3] * b[2] + v1[2] * b[3];
    v0 = o0; v1 = o1;
}
__device__ __forceinline__ float dot4(const f32x4 a) { return (a[0] * a[0] + a[1] * a[1]) + (a[2] * a[2] + a[3] * a[3]); }
struct EpiInProj {
    static constexpr bool PERM = true, AFTER_DRAIN = false;
    bf16_t* P; float* ssq; const float* rope;
    __device__ __forceinline__ void operator()(const f32x4 (&acc)[2][2][4][2], const Unit& u, int wr, int wc, int fr, int fq) const {
        const int pmw = u.pm % 9; const bool latent = pmw != 0;
        const int trow0 = (pmw - 1) * 256 + wr * 64 + fr, row0 = u.pm * BM + wr * 64 + fr;
#pragma unroll
        for (int bj = 0; bj < 2; ++bj) {
            const int seg = u.pn * 2 + bj, col0 = u.pn * BM + bj * HALF + wc * 32 + 8 * fq;
            int kind;
            if (seg < 2) kind = 1; else if (seg < 4) kind = 2; else if (seg < 12) kind = 0; else if (seg < 17) kind = 3; else kind = (wc < 2) ? 1 : 4;
            if (kind != 4) {
                const float sc = (kind == 2) ? 0.125f : 1.f; const bool dorope = latent && (kind == 1 || kind == 2);
                const int i0 = (col0 & 63) >> 1, slot = (u.pn - 6) * 8 + bj * 4 + wc;
#pragma unroll
                for (int ai = 0; ai < 2; ++ai)
#pragma unroll
                    for (int m = 0; m < 4; ++m) {
                        f32x4 v0 = acc[ai][bj][m][0] * sc, v1 = acc[ai][bj][m][1] * sc; const int roff = ai * HALF + m * 16;
                        if (dorope) rope8(v0, v1, rope + ((size_t)(trow0 + roff) * 32 + i0) * 2);
                        if (kind == 3) { float s = dot4(v0) + dot4(v1); s += __shfl_xor(s, 16); s += __shfl_xor(s, 32); if (fq == 0) ssq[(size_t)(row0 + roff) * 24 + slot] = s; }
                        store8(P + (size_t)(row0 + roff) * NINP + col0, v0, v1);
                    }
            }
        }
    }
};
struct EpiUpQ {
    static constexpr bool PERM = true, AFTER_DRAIN = false;
    bf16_t* Q;
    __device__ __forceinline__ void operator()(const f32x4 (&acc)[2][2][4][2], const Unit& u, int wr, int wc, int fr, int fq) const {
        const int row0 = u.pm * BM + wr * 64 + fr;
#pragma unroll
        for (int bj = 0; bj < 2; ++bj) {
            const int col0 = u.pn * BM + bj * HALF + wc * 32 + 8 * fq;
#pragma unroll
            for (int ai = 0; ai < 2; ++ai)
#pragma unroll
                for (int m = 0; m < 4; ++m) store8(Q + (size_t)(row0 + ai * HALF + m * 16) * NQ + col0, acc[ai][bj][m][0], acc[ai][bj][m][1]);
        }
    }
};
struct EpiUpKV {
    static constexpr bool PERM = true, AFTER_DRAIN = false;
    bf16_t* KV; const float* ssq;
    __device__ __forceinline__ void operator()(const f32x4 (&acc)[2][2][4][2], const Unit& u, int wr, int wc, int fr, int fq) const {
        const int row0 = u.pm * BM + wr * 64 + fr;
#pragma unroll
        for (int ai = 0; ai < 2; ++ai)
#pragma unroll
            for (int m = 0; m < 4; ++m) { const int roff = ai * HALF + m * 16;
                const float* s = ssq + (size_t)(row0 + roff) * 24 + 12; const f32x4 a = *(const f32x4*)s, b = *(const f32x4*)(s + 4);
                const float t = ((a[0] + a[1]) + (a[2] + a[3])) + ((b[0] + b[1]) + (b[2] + b[3])); const float rs = rsqrtf(t * (1.f / KVL) + EPS);
#pragma unroll
                for (int bj = 0; bj < 2; ++bj) { const int col0 = u.pn * BM + bj * HALF + wc * 32 + 8 * fq;
                    store8(KV + (size_t)(row0 + roff) * NKV + col0, acc[ai][bj][m][0] * rs, acc[ai][bj][m][1] * rs); }
                asm volatile("" ::: "memory"); }
    }
};
struct EpiGateRes {
    static constexpr bool PERM = true, AFTER_DRAIN = false;
    const float* base; float* out; const float* gate;
    __device__ __forceinline__ void operator()(const f32x4 (&acc)[2][2][4][2], const Unit& u, int wr, int wc, int fr, int fq) const {
        const int row0 = u.pm * BM + wr * 64 + fr, b = u.pm >> 3;
#pragma unroll
        for (int bj = 0; bj < 2; ++bj) {
            const int col0 = u.pn * BM + bj * HALF + wc * 32 + 8 * fq;
            const f32x4 g0 = *(const f32x4*)(gate + (size_t)b * 6144 + col0), g1 = *(const f32x4*)(gate + (size_t)b * 6144 + col0 + 4);
#pragma unroll
            for (int ai = 0; ai < 2; ++ai)
#pragma unroll
                for (int m = 0; m < 4; ++m) { const size_t off = (size_t)(row0 + ai * HALF + m * 16) * DM + col0;
                    const f32x4 x0 = *(const f32x4*)(base + off), x1 = *(const f32x4*)(base + off + 4);
                    *(f32x4*)(out + off) = x0 + g0 * acc[ai][bj][m][0]; *(f32x4*)(out + off + 4) = x1 + g1 * acc[ai][bj][m][1]; }
        }
    }
};
struct EpiRelu2 {
    static constexpr bool PERM = true, AFTER_DRAIN = false;
    bf16_t* H;
    __device__ __forceinline__ void operator()(const f32x4 (&acc)[2][2][4][2], const Unit& u, int wr, int wc, int fr, int fq) const {
        const int row0 = u.pm * BM + wr * 64 + fr;
#pragma unroll
        for (int bj = 0; bj < 2; ++bj) {
            const int col0 = u.pn * BM + bj * HALF + wc * 32 + 8 * fq;
#pragma unroll
            for (int ai = 0; ai < 2; ++ai)
#pragma unroll
                for (int m = 0; m < 4; ++m) { f32x4 v0 = acc[ai][bj][m][0], v1 = acc[ai][bj][m][1];
#pragma unroll
                    for (int e = 0; e < 4; ++e) { const float a = fmaxf(v0[e], 0.f), c = fmaxf(v1[e], 0.f); v0[e] = a * a; v1[e] = c * c; }
                    store8(H + (size_t)(row0 + ai * HALF + m * 16) * DFF + col0, v0, v1); }
        }
    }
};
template <class Epi, class Sched, bool ALIGN_EPI = false, bool SP2 = false>
__device__ __forceinline__ void gemm_phase(PG8_LAS unsigned char* lds, const Gemm g, const Sched& S, const Epi& E) {
    int tid_ = threadIdx.x; asm volatile("" : "+v"(tid_));
    const int tid = tid_, wid = __builtin_amdgcn_readfirstlane(tid >> 6), lane = tid & 63, wr = wid >> 2, wc = wid & 3, fr = lane & 15, fq = lane >> 4;
    const int K = g.K, nt = K / BK;
    unsigned voffA[2], voffB[2];
#pragma unroll
    for (int i = 0; i < 2; ++i) { int R, C; stage_rc(tid * 16 + i * 8192, R, C); const int Rb = Epi::PERM ? ((R & ~31) + perm32(R & 31)) : R;
        voffA[i] = (unsigned)(R * g.lda + C) * 2u; voffB[i] = (unsigned)(Rb * K + C) * 2u; }
    const size_t kstep = (size_t)(BK * 2);
    const size_t hstepA = (size_t)HALF * g.lda * 2, hstepB = (size_t)HALF * K * 2;
    const size_t tstepA = 2 * hstepA, tstepB = 2 * hstepB;
    const unsigned ldsw = (unsigned)wid * 1024u;
    const int aoff = lds_byte(wr * 64 + fr, fq * 8), boff = lds_byte(wc * 32 + fr, fq * 8);
#define PG8_SA(b, h) (((b) * 2 + (h)) * HTB)
#define PG8_SB(b, h) ((4 + (b) * 2 + (h)) * HTB)
#define PG8_STAGE(bufoff, gbase, voff) do { _Pragma("unroll") for (int _i = 0; _i < 2; ++_i) \
        __builtin_amdgcn_global_load_lds((const unsigned*)((const char*)(gbase) + (voff)[_i]), (PG8_LAS unsigned*)(lds + (bufoff) + ldsw + _i * 8192), 16, 0, 0); } while (0)
#define PG8_LDA(dst, b, h) do { _Pragma("unroll") for (int m = 0; m < 4; ++m) _Pragma("unroll") for (int k = 0; k < 2; ++k) dst[m][k] = *(const PG8_LAS bf16x8*)(lds + PG8_SA(b, h) + aoff + m * 2048 + k * 1024); } while (0)
#define PG8_LDB(dst, b, h) do { _Pragma("unroll") for (int n = 0; n < 2; ++n) _Pragma("unroll") for (int k = 0; k < 2; ++k) dst[n][k] = *(const PG8_LAS bf16x8*)(lds + PG8_SB(b, h) + boff + n * 2048 + k * 1024); } while (0)
#define PG8_MMA(ai, bj, At, Bt) do { __builtin_amdgcn_s_setprio(1); _Pragma("unroll") for (int m = 0; m < 4; ++m) _Pragma("unroll") for (int n = 0; n < 2; ++n) _Pragma("unroll") for (int k = 0; k < 2; ++k) \
        acc[ai][bj][m][n] = __builtin_amdgcn_mfma_f32_16x16x32_bf16(Bt[n][k], At[m][k], acc[ai][bj][m][n], 0, 0, 0); __builtin_amdgcn_s_setprio(0); } while (0)
#define PG8_WAIT_V(n) asm volatile("s_waitcnt vmcnt(" #n ")" ::: "memory")
#define PG8_WAIT_L(n) asm volatile("s_waitcnt lgkmcnt(" #n ")" ::: "memory")
#define PG8_BAR __builtin_amdgcn_s_barrier()
#define PG8_SCHED __builtin_amdgcn_sched_barrier(0)
    Unit cur, nxt; int ui = 0;
    if (!S.next(0, cur)) return;
    f32x4 acc[2][2][4][2];
#pragma unroll
    for (int a = 0; a < 2; ++a)
#pragma unroll
        for (int b = 0; b < 2; ++b)
#pragma unroll
            for (int m = 0; m < 4; ++m)
#pragma unroll
                for (int n = 0; n < 2; ++n) acc[a][b][m][n] = (f32x4){0.f, 0.f, 0.f, 0.f};
    bf16x8 At[4][2], B0[2][2], B1[2][2];
    const char* cA = (const char*)g.A + (size_t)cur.pm * tstepA; const char* cB = (const char*)g.Bt + (size_t)cur.pn * tstepB;
    S.a_ready(cur);
    if constexpr (SP2) {
        PG8_STAGE(PG8_SB(0, 0), cB, voffB); PG8_STAGE(PG8_SB(0, 1), cB + hstepB, voffB); PG8_STAGE(PG8_SA(0, 0), cA, voffA); PG8_STAGE(PG8_SA(0, 1), cA + hstepA, voffA);
        if (wr == 1) PG8_BAR;
        PG8_WAIT_V(2); PG8_BAR;
        PG8_STAGE(PG8_SB(1, 0), cB + kstep, voffB); PG8_STAGE(PG8_SA(1, 0), cA + kstep, voffA); PG8_STAGE(PG8_SB(1, 1), cB + hstepB + kstep, voffB);
        PG8_WAIT_V(6); PG8_BAR;
    } else {
        PG8_STAGE(PG8_SB(0, 0), cB, voffB); PG8_STAGE(PG8_SA(0, 0), cA, voffA); PG8_STAGE(PG8_SB(0, 1), cB + hstepB, voffB); PG8_STAGE(PG8_SA(0, 1), cA + hstepA, voffA);
        if (wr == 1) PG8_BAR;
        PG8_WAIT_V(4); PG8_BAR;
        PG8_STAGE(PG8_SB(1, 0), cB + kstep, voffB); PG8_STAGE(PG8_SA(1, 0), cA + kstep, voffA); PG8_STAGE(PG8_SB(1, 1), cB + hstepB + kstep, voffB);
        PG8_WAIT_V(6); PG8_BAR;
    }
    for (;;) {
        const bool has_next = S.next(ui + 1, nxt);
        const char* nA = has_next ? (const char*)g.A + (size_t)nxt.pm * tstepA : cA; const char* nB = has_next ? (const char*)g.Bt + (size_t)nxt.pn * tstepB : cB;
#pragma nounroll
        for (int t = 0; t < nt; t += 2) {
            const bool last = (t == nt - 2);
            const char* a1 = cA + (size_t)(t + 1) * kstep;
            const char* a2 = last ? nA : cA + (size_t)(t + 2) * kstep; const char* b2 = last ? nB : cB + (size_t)(t + 2) * kstep;
            const char* a3 = a2 + kstep; const char* b3 = b2 + kstep;
            if (last && has_next) S.a_ready(nxt);
            if constexpr (SP2) {
            PG8_LDB(B0, 0, 0); PG8_LDB(B1, 0, 1); PG8_SCHED; PG8_LDA(At, 0, 0); PG8_STAGE(PG8_SA(1, 1), a1 + hstepA, voffA);
            PG8_WAIT_V(8); PG8_WAIT_L(0); PG8_BAR; PG8_MMA(0, 0, At, B0); PG8_MMA(0, 1, At, B1); PG8_BAR; PG8_SCHED;
            PG8_LDA(At, 0, 1); PG8_STAGE(PG8_SB(0, 0), b2, voffB); PG8_STAGE(PG8_SB(0, 1), b2 + hstepB, voffB); PG8_STAGE(PG8_SA(0, 0), a2, voffA);
            PG8_WAIT_V(8); PG8_WAIT_L(0); PG8_BAR; PG8_MMA(1, 0, At, B0); PG8_MMA(1, 1, At, B1); PG8_BAR; PG8_SCHED;
            PG8_LDB(B0, 1, 0); PG8_LDB(B1, 1, 1); PG8_SCHED; PG8_LDA(At, 1, 0); PG8_STAGE(PG8_SA(0, 1), a2 + hstepA, voffA);
            PG8_WAIT_V(8); PG8_WAIT_L(0); PG8_BAR; PG8_MMA(0, 0, At, B0); PG8_MMA(0, 1, At, B1); PG8_BAR; PG8_SCHED;
            PG8_LDA(At, 1, 1); PG8_STAGE(PG8_SB(1, 0), b3, voffB); PG8_STAGE(PG8_SB(1, 1), b3 + hstepB, voffB); PG8_STAGE(PG8_SA(1, 0), a3, voffA);
            PG8_WAIT_V(8); PG8_WAIT_L(0); PG8_BAR; PG8_MMA(1, 0, At, B0); PG8_MMA(1, 1, At, B1); PG8_BAR; PG8_SCHED;
            } else {
            PG8_LDB(B0, 0, 0); PG8_SCHED; PG8_LDA(At, 0, 0); PG8_STAGE(PG8_SA(1, 1), a1 + hstepA, voffA);
            PG8_WAIT_L(8); PG8_BAR; PG8_WAIT_L(0); PG8_MMA(0, 0, At, B0); PG8_BAR; PG8_SCHED;
            PG8_LDB(B1, 0, 1); PG8_STAGE(PG8_SB(0, 0), b2, voffB);
            PG8_BAR; PG8_WAIT_L(0); PG8_MMA(0, 1, At, B1); PG8_BAR;
            PG8_LDA(At, 0, 1); PG8_STAGE(PG8_SA(0, 0), a2, voffA);
            PG8_BAR; PG8_WAIT_L(0); PG8_MMA(1, 0, At, B0); PG8_BAR; PG8_SCHED;
            PG8_STAGE(PG8_SB(0, 1), b2 + hstepB, voffB);
            PG8_WAIT_V(6); PG8_BAR; PG8_MMA(1, 1, At, B1); PG8_BAR;
            PG8_LDB(B0, 1, 0); PG8_SCHED; PG8_LDA(At, 1, 0); PG8_STAGE(PG8_SA(0, 1), a2 + hstepA, voffA);
            PG8_WAIT_L(8); PG8_BAR; PG8_WAIT_L(0); PG8_MMA(0, 0, At, B0); PG8_BAR; PG8_SCHED;
            PG8_LDB(B1, 1, 1); PG8_STAGE(PG8_SB(1, 0), b3, voffB);
            PG8_BAR; PG8_WAIT_L(0); PG8_MMA(0, 1, At, B1); PG8_BAR;
            PG8_LDA(At, 1, 1); PG8_STAGE(PG8_SA(1, 0), a3, voffA);
            PG8_BAR; PG8_WAIT_L(0); PG8_MMA(1, 0, At, B0); PG8_BAR; PG8_SCHED;
            PG8_STAGE(PG8_SB(1, 1), b3 + hstepB, voffB);
            PG8_WAIT_V(6); PG8_BAR; PG8_MMA(1, 1, At, B1); PG8_BAR;
            }
        }
        if constexpr (ALIGN_EPI) { if (wr == 0) PG8_BAR; }
        if constexpr (!Epi::AFTER_DRAIN) { E(acc, cur, wr, wc, fr, fq); S.done(cur); }
        if (!has_next) break;
#pragma unroll
        for (int a = 0; a < 2; ++a)
#pragma unroll
            for (int b = 0; b < 2; ++b)
#pragma unroll
                for (int m = 0; m < 4; ++m)
#pragma unroll
                    for (int n = 0; n < 2; ++n) acc[a][b][m][n] = (f32x4){0.f, 0.f, 0.f, 0.f};
        cur = nxt; cA = nA; cB = nB; ++ui;
        if constexpr (ALIGN_EPI) { if (wr == 1) PG8_BAR; }
    }
    PG8_WAIT_V(0);
    if constexpr (!ALIGN_EPI) { if (wr == 0) PG8_BAR; }
    PG8_BAR;
    if constexpr (Epi::AFTER_DRAIN) { E.fused(acc, cur, wr, wc, fr, fq, lds, wid, lane); S.done(cur); }
#undef PG8_SA
#undef PG8_SB
#undef PG8_STAGE
#undef PG8_LDA
#undef PG8_LDB
#undef PG8_MMA
#undef PG8_WAIT_V
#undef PG8_WAIT_L
#undef PG8_BAR
#undef PG8_SCHED
}
}
namespace att {
using bf16 = __hip_bfloat16;
using bf16x8 = __attribute__((ext_vector_type(8))) short;
using s16x4  = __attribute__((ext_vector_type(4))) short;
using f32x16 = __attribute__((ext_vector_type(16))) float;
using u32x4  = __attribute__((ext_vector_type(4))) unsigned;
using f32x4  = __attribute__((ext_vector_type(4))) float;
constexpr int NW = 8, QBLK = 32, KVBLK = 64;
constexpr float SCALE = 0.07216878364870323f;
constexpr float THR = 8.f;
constexpr int SDEPTH = ATT_SDEPTH;
constexpr int SHM_V = 16384, SHM_K = 24576;
constexpr int LDQ = NQ, LDK = NKV, LDP = NINP, LDO = DM;
constexpr int SHM_ATTN = 2 * SHM_V + 2 * SHM_K + NW * 64 * 4;
#define KSWZ(row, colB) ((row) * 384 + ((colB) ^ (((row) & 7) << 4)))
#define SBAR() __builtin_amdgcn_sched_barrier(0)
__device__ __forceinline__ int crow(int r, int hi) { return (r & 3) + 8 * (r >> 2) + 4 * hi; }
__device__ __forceinline__ unsigned cvtpk(float lo, float hi) { unsigned r; asm volatile("v_cvt_pk_bf16_f32 %0, %1, %2" : "=v"(r) : "v"(lo), "v"(hi)); return r; }
__device__ __forceinline__ float bf2f(short s) { return __uint_as_float(((unsigned)(unsigned short)s) << 16); }
__device__ __forceinline__ bf16x8 ld8(const bf16* p) { return *reinterpret_cast<const bf16x8*>(p); }
__device__ __forceinline__ bf16x8 scale8(bf16x8 v, float s) {
  u32x4 w = {cvtpk(bf2f(v[0]) * s, bf2f(v[1]) * s), cvtpk(bf2f(v[2]) * s, bf2f(v[3]) * s), cvtpk(bf2f(v[4]) * s, bf2f(v[5]) * s), cvtpk(bf2f(v[6]) * s, bf2f(v[7]) * s)};
  return *reinterpret_cast<bf16x8*>(&w);
}

__device__ __forceinline__ void partialSM(f32x16& p0, f32x16& p1, float& m_reg, float& mn, float& alpha) {
  constexpr float C = SCALE * 1.4426950408889634f;
  float pmax = p0[0]; for (int r = 1; r < 16; ++r) pmax = fmaxf(pmax, p0[r]); for (int r = 0; r < 16; ++r) pmax = fmaxf(pmax, p1[r]);
  { auto rr = __builtin_amdgcn_permlane32_swap(__float_as_uint(pmax), __float_as_uint(pmax), false, false);
    pmax = fmaxf(__uint_as_float(rr[0]), __uint_as_float(rr[1])); }
  if (__builtin_expect(__all(pmax - m_reg <= THR / SCALE), 1)) { mn = m_reg; alpha = 1.f; }
  else { mn = fmaxf(m_reg, pmax); alpha = __builtin_amdgcn_exp2f((m_reg - mn) * C); m_reg = mn; }
  float mnC = -mn * C;
  for (int r = 0; r < 16; ++r) p0[r] = fmaf(p0[r], C, mnC); for (int r = 0; r < 16; ++r) p1[r] = fmaf(p1[r], C, mnC);
  for (int r = 0; r < 16; ++r) p0[r] = __builtin_amdgcn_exp2f(p0[r]);
}
#define PK4(P, BASE, OUT) do { unsigned a0 = cvtpk(P[BASE + 0], P[BASE + 1]), a1 = cvtpk(P[BASE + 2], P[BASE + 3]);   \
    unsigned b0 = cvtpk(P[BASE + 4], P[BASE + 5]), b1 = cvtpk(P[BASE + 6], P[BASE + 7]);                              \
    auto r0 = __builtin_amdgcn_permlane32_swap(a0, b0, false, false); auto r1 = __builtin_amdgcn_permlane32_swap(a1, b1, false, false); \
    u32x4 w = {r0[0], r1[0], r0[1], r1[1]}; OUT = *reinterpret_cast<bf16x8*>(&w); } while (0)
__device__ __forceinline__ void finishSM(f32x16& p0, f32x16& p1, float alpha, float& l_reg, bf16x8& pa0, bf16x8& pa1, bf16x8& pa2, bf16x8& pa3) {
  for (int r = 0; r < 16; ++r) p1[r] = __builtin_amdgcn_exp2f(p1[r]);
  float ps = 0; for (int r = 0; r < 16; ++r) ps += p0[r]; for (int r = 0; r < 16; ++r) ps += p1[r];
  { auto rr = __builtin_amdgcn_permlane32_swap(__float_as_uint(ps), __float_as_uint(ps), false, false);
    ps = __uint_as_float(rr[0]) + __uint_as_float(rr[1]); }
  l_reg = l_reg * alpha + ps;
  PK4(p0, 0, pa0); PK4(p0, 8, pa1); PK4(p1, 0, pa2); PK4(p1, 8, pa3);
}
__device__ __forceinline__ void qkt(f32x16& p0, f32x16& p1, const bf16* Ks, const bf16x8* qr, int r32, int hi) {
  p0 = f32x16{}; p1 = f32x16{};
#pragma unroll
  for (int d0 = 0; d0 < 12; ++d0) { int cb = (d0 * 16 + hi * 8) * 2;
    bf16x8 b0 = *reinterpret_cast<const bf16x8*>((const char*)Ks + KSWZ(r32, cb));
    bf16x8 b1 = *reinterpret_cast<const bf16x8*>((const char*)Ks + KSWZ(32 + r32, cb));
    p0 = __builtin_amdgcn_mfma_f32_32x32x16_bf16(b0, qr[d0], p0, 0, 0, 0);
    p1 = __builtin_amdgcn_mfma_f32_32x32x16_bf16(b1, qr[d0], p1, 0, 0, 0); }
}
__device__ __forceinline__ int v_st(int k, int c) { const int kk = (k & ~0xC) | ((k & 4) << 1) | ((k & 8) >> 1); return ((kk >> 3) * 4 + (c >> 5)) * 512 + ((kk & 7) * 32 + (c & 31)) * 2; }
__device__ __forceinline__ int v_rd_base(int lane) { return ((lane & 3) << 3) | (((lane >> 2) & 3) << 6) | (((lane >> 4) & 1) << 5) | (((lane >> 5) & 1) << 8); }
constexpr int v_rd_off(int d0, int ks, int half) { return d0 * 512 + ks * 4096 + half * 2048; }
template <int OFF> __device__ __forceinline__ s16x4 tr_read(int vb) {
  s16x4 r; asm volatile("ds_read_b64_tr_b16 %0, %1 offset:%2" : "=&v"(r) : "v"(vb), "i"(OFF) : "memory"); return r;
}
#define PKF(L, H) (bf16x8){L[0], L[1], L[2], L[3], H[0], H[1], H[2], H[3]}
template <int D0> __device__ __forceinline__ void pv_one(f32x16& od, int vb, bf16x8 pa0, bf16x8 pa1, bf16x8 pa2, bf16x8 pa3) {
  const s16x4 l0 = tr_read<v_rd_off(D0, 0, 0)>(vb), h0 = tr_read<v_rd_off(D0, 0, 1)>(vb), l1 = tr_read<v_rd_off(D0, 1, 0)>(vb), h1 = tr_read<v_rd_off(D0, 1, 1)>(vb);
  const s16x4 l2 = tr_read<v_rd_off(D0, 2, 0)>(vb), h2 = tr_read<v_rd_off(D0, 2, 1)>(vb), l3 = tr_read<v_rd_off(D0, 3, 0)>(vb), h3 = tr_read<v_rd_off(D0, 3, 1)>(vb);
  asm volatile("s_waitcnt lgkmcnt(0)" ::: "memory"); SBAR();
  od = __builtin_amdgcn_mfma_f32_32x32x16_bf16(pa0, PKF(l0, h0), od, 0, 0, 0);
  od = __builtin_amdgcn_mfma_f32_32x32x16_bf16(pa1, PKF(l1, h1), od, 0, 0, 0);
  od = __builtin_amdgcn_mfma_f32_32x32x16_bf16(pa2, PKF(l2, h2), od, 0, 0, 0);
  od = __builtin_amdgcn_mfma_f32_32x32x16_bf16(pa3, PKF(l3, h3), od, 0, 0, 0);
}
__device__ __forceinline__ void pv_d0(f32x16* o, int vb, bf16x8 pa0, bf16x8 pa1, bf16x8 pa2, bf16x8 pa3) {
  pv_one<0>(o[0], vb, pa0, pa1, pa2, pa3); pv_one<1>(o[1], vb, pa0, pa1, pa2, pa3); pv_one<2>(o[2], vb, pa0, pa1, pa2, pa3); pv_one<3>(o[3], vb, pa0, pa1, pa2, pa3);
}
__device__ __forceinline__ void attn_body(const bf16* __restrict__ Qb, const bf16* __restrict__ Kh, const bf16* __restrict__ Vh, const bf16* __restrict__ Pe,
                                          bf16* __restrict__ Ob, const float* __restrict__ ropeq, const float* __restrict__ ssqq, int seq, char* lds) {
  int tid_ = threadIdx.x; asm volatile("" : "+v"(tid_));
  const int tid = tid_, wid = tid >> 6, lane = tid & 63, r32 = lane & 31, hi = lane >> 5;
  bf16* V_lds = (bf16*)lds; bf16* K_lds = (bf16*)(lds + 2 * SHM_V);
  float* ws = (float*)(lds + 2 * SHM_V + 2 * SHM_K) + wid * 64; float* li_l = ws; float* al_l = ws + 32;
  float m_reg = -1e30f, l_reg = 0; f32x16 o[4] = {}; bf16x8 qr[12];
  const bf16* Qw = Qb + (long)(wid * QBLK + r32) * LDQ + hi * 8;
  float qrs; { const float* s = ssqq + (long)(wid * QBLK + r32) * 24; const f32x4 a = *(const f32x4*)s, b = *(const f32x4*)(s + 4), c = *(const f32x4*)(s + 8);
    qrs = rsqrtf((((a[0] + a[1]) + (a[2] + a[3])) + ((b[0] + b[1]) + (b[2] + b[3])) + ((c[0] + c[1]) + (c[2] + c[3]))) * (1.f / QL) + EPS); }
#pragma unroll
  for (int d0 = 0; d0 < 8; ++d0) qr[d0] = scale8(ld8(Qw + d0 * 16), qrs);
  { const float* rp = ropeq + ((long)(wid * QBLK + r32) * 32 + hi * 4) * 2;
#pragma unroll
    for (int d0 = 0; d0 < 4; ++d0) { const bf16x8 raw = ld8(Qw + (8 + d0) * 16); const f32x4 ca = *(const f32x4*)(rp + d0 * 16), cb_ = *(const f32x4*)(rp + d0 * 16 + 4);
      const float x0 = bf2f(raw[0]) * qrs, x1 = bf2f(raw[1]) * qrs, x2 = bf2f(raw[2]) * qrs, x3 = bf2f(raw[3]) * qrs, x4 = bf2f(raw[4]) * qrs, x5 = bf2f(raw[5]) * qrs, x6 = bf2f(raw[6]) * qrs, x7 = bf2f(raw[7]) * qrs;
      u32x4 w = {cvtpk(x0 * ca[0] - x1 * ca[1], x1 * ca[0] + x0 * ca[1]), cvtpk(x2 * ca[2] - x3 * ca[3], x3 * ca[2] + x2 * ca[3]),
                 cvtpk(x4 * cb_[0] - x5 * cb_[1], x5 * cb_[0] + x4 * cb_[1]), cvtpk(x6 * cb_[2] - x7 * cb_[3], x7 * cb_[2] + x6 * cb_[3])};
      qr[8 + d0] = *reinterpret_cast<bf16x8*>(&w); } }
  const int sr = tid >> 4, sc = (tid & 15) * 8, vst0 = v_st(sr, sc), vst1 = v_st(32 + sr, sc);
  const int pr = tid >> 3, pc = (tid & 7) * 8;
  const int vb0 = (int)(uintptr_t)V_lds + v_rd_base(lane);
  bf16x8 vs0, vs1, ks0, ks1, kp;
#define SLOAD(k0) do { vs0 = ld8(&Vh[(long)((k0) + sr) * LDK + sc]); vs1 = ld8(&Vh[(long)((k0) + 32 + sr) * LDK + sc]); \
    ks0 = ld8(&Kh[(long)((k0) + sr) * LDK + sc]); ks1 = ld8(&Kh[(long)((k0) + 32 + sr) * LDK + sc]); kp = ld8(&Pe[(long)((k0) + pr) * LDP + pc]); } while (0)
#define SWRITE(b) do { *(bf16x8*)((char*)V_lds + (b) * SHM_V + vst0) = vs0; *(bf16x8*)((char*)V_lds + (b) * SHM_V + vst1) = vs1; const int kc = sc * 2; \
    *(bf16x8*)((char*)K_lds + (b) * SHM_K + KSWZ(sr, kc)) = ks0; *(bf16x8*)((char*)K_lds + (b) * SHM_K + KSWZ(32 + sr, kc)) = ks1;                  \
    *(bf16x8*)((char*)K_lds + (b) * SHM_K + KSWZ(pr, 256 + pc * 2)) = kp; } while (0)
#define RESC(a) do { if (__any((a) < 1.f)) { if (hi == 0) al_l[r32] = (a); asm volatile("s_waitcnt lgkmcnt(0)" ::: "memory"); \
    for (int d = 0; d < 4; ++d) for (int r = 0; r < 16; ++r) o[d][r] *= al_l[crow(r, hi)]; } } while (0)
  const int NT = seq / KVBLK;
  SLOAD(0); asm volatile("s_waitcnt vmcnt(0)" ::: "memory"); SWRITE(0); SLOAD(KVBLK); __syncthreads();
  for (int j = 0; j < NT; ++j) {
    const int bs = j & 1;
    f32x16 p0, p1; float mn, al; bf16x8 pa0, pa1, pa2, pa3;
    qkt(p0, p1, (const bf16*)((const char*)K_lds + bs * SHM_K), qr, r32, hi);
    partialSM(p0, p1, m_reg, mn, al);
    RESC(al);
    finishSM(p0, p1, al, l_reg, pa0, pa1, pa2, pa3); SBAR();
    pv_d0(o, vb0 + bs * SHM_V, pa0, pa1, pa2, pa3);
    if (j + 1 < NT) { SWRITE(bs ^ 1); if (j + 2 < NT) SLOAD((j + 2) * KVBLK); }
    __syncthreads();
  }
  if (hi == 0) li_l[r32] = l_reg; asm volatile("s_waitcnt lgkmcnt(0)" ::: "memory");
  float rli[16];
#pragma unroll
  for (int r = 0; r < 16; ++r) rli[r] = __builtin_amdgcn_rcpf(li_l[crow(r, hi)]);
  bf16* Ow = Ob + (long)(wid * QBLK) * LDO;
#pragma unroll
  for (int r = 0; r < 16; ++r) { int orow = crow(r, hi);
    for (int d0 = 0; d0 < 4; ++d0) Ow[(long)orow * LDO + d0 * 32 + r32] = __float2bfloat16(o[d0][r] * rli[r]); }
#undef SLOAD
#undef SWRITE
#undef RESC
}

__device__ __forceinline__ void ret_states(int item, const bf16* __restrict__ P, bf16* __restrict__ St, const float* dec_f, const float* dec_b, char* lds) {
  int tid_ = threadIdx.x; asm volatile("" : "+v"(tid_));
  const int tid = tid_, wid = tid >> 6, lane = tid & 63, r32 = lane & 31, hi = lane >> 5;
  const int b = item >> 3, h = (item >> 1) & 3, dir = item & 1;
  const float dl = (dir ? dec_b : dec_f)[h];
  const float l2 = -log1pf(expf(-dl)) * 1.4426950408889634f;
  const float decay128 = exp2f(l2 * 128.f);
  char* Kimg = lds; char* Vimg = lds + 32768;
  const int db = wid & 1, vbk = wid >> 1;
  f32x16 acc = {};
  bf16x8 kreg[2], vreg[4]; int koff[2], voff[4]; float kw[2];
#pragma unroll
  for (int q = 0; q < 2; ++q) { const int c = tid + 512 * q, row = c >> 3, col = (c & 7) * 8; koff[q] = (row >> 6) * 16384 + v_st(row & 63, col); kw[q] = exp2f(l2 * (float)(dir ? row : 127 - row)); }
#pragma unroll
  for (int q = 0; q < 4; ++q) { const int c = tid + 512 * q, row = c >> 4, col = (c & 15) * 8; voff[q] = (row >> 6) * 16384 + v_st(row & 63, col); }
  const int ka = (int)(uintptr_t)Kimg + v_rd_base(lane) + db * 512, va = (int)(uintptr_t)Vimg + v_rd_base(lane) + vbk * 512;
#define R1_ROWBASE(s) (b * TOK + (dir == 0 ? ((s) < 2 ? (s) * 128 : 256 + ((s) - 2) * 128) : ((s) < 2 ? (1 - (s)) * 128 : 256 + (17 - (s)) * 128)))
#define R1_LOAD(s) do { const long rb = R1_ROWBASE(s); \
    _Pragma("unroll") for (int q = 0; q < 2; ++q) { const int c = tid + 512 * q; kreg[q] = ld8(P + (rb + (c >> 3)) * LDP + C_RK + h * 64 + (c & 7) * 8); } \
    _Pragma("unroll") for (int q = 0; q < 4; ++q) { const int c = tid + 512 * q; vreg[q] = ld8(P + (rb + (c >> 4)) * LDP + C_RV + h * 128 + (c & 15) * 8); } } while (0)
#define R1_STORE(n) do { bf16* dst = St + ((long)((b * 4 + h) * 16 + (n)) * 128 + dir * 64 + db * 32) * 128 + vbk * 32 + r32; \
    _Pragma("unroll") for (int r = 0; r < 16; ++r) dst[crow(r, hi) * 128] = __float2bfloat16(acc[r]); } while (0)
  R1_LOAD(0);
  for (int s = 0; s < 17; ++s) {
#pragma unroll
    for (int q = 0; q < 2; ++q) *(bf16x8*)(Kimg + koff[q]) = scale8(kreg[q], kw[q]);
#pragma unroll
    for (int q = 0; q < 4; ++q) *(bf16x8*)(Vimg + voff[q]) = vreg[q];
    __syncthreads();
    if (s + 1 < 17) R1_LOAD(s + 1);
    if (s >= 2) { const int n = dir == 0 ? s - 2 : 17 - s; R1_STORE(n); }
#pragma unroll
    for (int r = 0; r < 16; ++r) acc[r] *= decay128;
#define R1_STEP(KT, KS) do { const s16x4 al = tr_read<(KT) * 16384 + v_rd_off(0, KS, 0)>(ka), ah = tr_read<(KT) * 16384 + v_rd_off(0, KS, 1)>(ka); \
      const s16x4 bl = tr_read<(KT) * 16384 + v_rd_off(0, KS, 0)>(va), bh = tr_read<(KT) * 16384 + v_rd_off(0, KS, 1)>(va); \
      asm volatile("s_waitcnt lgkmcnt(0)" ::: "memory"); SBAR(); \
      acc = __builtin_amdgcn_mfma_f32_32x32x16_bf16(PKF(al, ah), PKF(bl, bh), acc, 0, 0, 0); } while (0)
    R1_STEP(0, 0); R1_STEP(0, 1); R1_STEP(0, 2); R1_STEP(0, 3); R1_STEP(1, 0); R1_STEP(1, 1); R1_STEP(1, 2); R1_STEP(1, 3);
    __syncthreads();
  }
  { const int n = dir == 0 ? 15 : 0; R1_STORE(n); }
#undef R1_STEP
#undef R1_LOAD
#undef R1_STORE
#undef R1_ROWBASE
}
template <int DV2> __device__ __forceinline__ void pv_two(f32x16* o, int vb, bf16x8 pa0, bf16x8 pa1, bf16x8 pa2, bf16x8 pa3) {
  pv_one<0>(o[0], vb, pa0, pa1, pa2, pa3); pv_one<1>(o[1], vb, pa0, pa1, pa2, pa3);
}
__device__ __forceinline__ void ret_chunk(int b, int h, int n, const bf16* __restrict__ P, const bf16* __restrict__ St, const float* __restrict__ g_ret,
                                          float l2f, float l2b, bf16* __restrict__ Y, char* lds) {
  int tid_ = threadIdx.x; asm volatile("" : "+v"(tid_));
  const int tid = tid_, wid = tid >> 6, lane = tid & 63, r32 = lane & 31, hi = lane >> 5, wq = wid & 3, dvh = wid >> 2;
  char* Kt = lds; char* Vimg = lds + 16384; char* Simg = lds + 49152; float* Ot = (float*)lds;
  const long rowbase = (long)b * TOK + 256 + n * 128;
  bf16x8 qr[4];
  { const bf16* qp = P + (rowbase + 32 * wq + r32) * LDP + C_RQ + h * 64 + hi * 8;
#pragma unroll
    for (int d0 = 0; d0 < 4; ++d0) qr[d0] = ld8(qp + d0 * 16); }
#define KS128(row, colB) ((row) * 128 + ((colB) ^ (((row) & 7) << 4)))
  { bf16x8 kreg[2], vreg[4], sreg[4];
#pragma unroll
    for (int q = 0; q < 2; ++q) { const int c = tid + 512 * q; kreg[q] = ld8(P + (rowbase + (c >> 3)) * LDP + C_RK + h * 64 + (c & 7) * 8); }
#pragma unroll
    for (int q = 0; q < 4; ++q) { const int c = tid + 512 * q; vreg[q] = ld8(P + (rowbase + (c >> 4)) * LDP + C_RV + h * 128 + (c & 15) * 8);
      sreg[q] = ld8(St + ((long)((b * 4 + h) * 16 + n) * 128 + (c >> 4)) * 128 + (c & 15) * 8); }
#pragma unroll
    for (int q = 0; q < 2; ++q) { const int c = tid + 512 * q, row = c >> 3, col = (c & 7) * 8; *(bf16x8*)(Kt + KS128(row, col * 2)) = kreg[q]; }
#pragma unroll
    for (int q = 0; q < 4; ++q) { const int c = tid + 512 * q, row = c >> 4, col = (c & 15) * 8, off = (row >> 6) * 16384 + v_st(row & 63, col);
      *(bf16x8*)(Vimg + off) = vreg[q]; *(bf16x8*)(Simg + off) = sreg[q]; } }
  __syncthreads();
  f32x16 o[2] = {};
  const int i = 32 * wq + r32;
  const int vb = (int)(uintptr_t)Vimg + v_rd_base(lane) + dvh * 1024, sb = (int)(uintptr_t)Simg + v_rd_base(lane) + dvh * 1024;
#pragma nounroll
  for (int kt = 0; kt < 2; ++kt) {
    f32x16 p0 = {}, p1 = {};
#pragma unroll
    for (int d0 = 0; d0 < 4; ++d0) { const int cb = (d0 * 16 + hi * 8) * 2;
      const bf16x8 b0 = *reinterpret_cast<const bf16x8*>(Kt + KS128(64 * kt + r32, cb)), b1 = *reinterpret_cast<const bf16x8*>(Kt + KS128(64 * kt + 32 + r32, cb));
      p0 = __builtin_amdgcn_mfma_f32_32x32x16_bf16(b0, qr[d0], p0, 0, 0, 0); p1 = __builtin_amdgcn_mfma_f32_32x32x16_bf16(b1, qr[d0], p1, 0, 0, 0); }
#pragma unroll
    for (int r = 0; r < 16; ++r) { const int d0_ = i - (64 * kt + crow(r, hi)), d1_ = d0_ - 32;
      const float a0 = d0_ > 0 ? l2f * (float)d0_ : l2b * (float)(-d0_), a1 = d1_ > 0 ? l2f * (float)d1_ : l2b * (float)(-d1_);
      const float m0 = __builtin_amdgcn_exp2f(a0) * (d0_ == 0 ? 2.f : 1.f), m1 = __builtin_amdgcn_exp2f(a1) * (d1_ == 0 ? 2.f : 1.f);
      p0[r] *= m0; p1[r] *= m1; }
    bf16x8 pa0, pa1, pa2, pa3; PK4(p0, 0, pa0); PK4(p0, 8, pa1); PK4(p1, 0, pa2); PK4(p1, 8, pa3);
    pv_two<0>(o, vb + kt * 16384, pa0, pa1, pa2, pa3);
  }
  { const float sf = __builtin_amdgcn_exp2f(l2f * (float)(i + 1)), sbw = __builtin_amdgcn_exp2f(l2b * (float)(128 - i));
    pv_two<0>(o, sb, scale8(qr[0], sf), scale8(qr[1], sf), scale8(qr[2], sf), scale8(qr[3], sf));
    pv_two<0>(o, sb + 16384, scale8(qr[0], sbw), scale8(qr[1], sbw), scale8(qr[2], sbw), scale8(qr[3], sbw)); }
  __syncthreads();
#pragma unroll
  for (int d = 0; d < 2; ++d)
#pragma unroll
    for (int r = 0; r < 16; ++r) Ot[(32 * wq + crow(r, hi)) * 132 + 64 * dvh + 32 * d + r32] = o[d][r];
  __syncthreads();
  { const int row = tid >> 2, qd = tid & 3; const float* op = Ot + row * 132 + qd * 32;
    f32x4 v[8]; float s = 0.f;
#pragma unroll
    for (int j = 0; j < 8; ++j) { v[j] = *(const f32x4*)(op + 4 * j); s += (v[j][0] + v[j][1]) + (v[j][2] + v[j][3]); }
    s += __shfl_xor(s, 1); s += __shfl_xor(s, 2); const float mu = s * (1.f / 128.f); float q2 = 0.f;
#pragma unroll
    for (int j = 0; j < 8; ++j) { v[j] = v[j] - mu; q2 += (v[j][0] * v[j][0] + v[j][1] * v[j][1]) + (v[j][2] * v[j][2] + v[j][3] * v[j][3]); }
    q2 += __shfl_xor(q2, 1); q2 += __shfl_xor(q2, 2); const float rstd = rsqrtf(q2 * (1.f / 128.f) + EPS);
    const bf16* gp = P + (rowbase + row) * LDP + C_RG + h * 128 + qd * 32; const float* grp = g_ret + h * 128 + qd * 32;
    bf16* yp = Y + ((long)b * SEQ + n * 128 + row) * DM + h * 128 + qd * 32;
#pragma unroll
    for (int j = 0; j < 4; ++j) { const bf16x8 g8 = ld8(gp + 8 * j); const f32x4 ga = *(const f32x4*)(grp + 8 * j), gb = *(const f32x4*)(grp + 8 * j + 4); float y[8];
#pragma unroll
      for (int e = 0; e < 8; ++e) { const float gt = bf2f(g8[e]), sg = gt / (1.f + __expf(-gt)); const float ov = e < 4 ? v[2 * j][e] * ga[e] : v[2 * j + 1][e - 4] * gb[e - 4]; y[e] = ov * rstd * sg; }
      u32x4 w = {cvtpk(y[0], y[1]), cvtpk(y[2], y[3]), cvtpk(y[4], y[5]), cvtpk(y[6], y[7])}; *(u32x4*)(yp + 8 * j) = w; } }
  __syncthreads();
#undef KS128
}
#undef KSWZ
#undef SBAR
#undef PK4
#undef PKF
}
#define LAS __attribute__((address_space(3)))
typedef unsigned short bf16r;
typedef unsigned v4u __attribute__((ext_vector_type(4)));
typedef float f32x4 __attribute__((ext_vector_type(4)));
__device__ __forceinline__ unsigned f2bf(float f) { unsigned u = __builtin_bit_cast(unsigned, f); return (u + 0x7fffu + ((u >> 16) & 1u)) >> 16; }
__device__ __forceinline__ unsigned pk2(float lo, float hi) { return f2bf(lo) | (f2bf(hi) << 16); }
__device__ __forceinline__ float wave_sum(float v) {
#pragma unroll
    for (int o = 1; o < 64; o <<= 1) v += __shfl_xor(v, o);
    return v;
}
__device__ __forceinline__ int ileave64(int n) { const int d = n & 63; return (n & ~63) + (d < 32 ? 2 * d : 2 * (d - 32) + 1); }
template <int MAP> __device__ __forceinline__ int colmap(int n) {
    if (MAP == 1) return (n < 512 || n >= C_KPE) ? ileave64(n) : n;
    if (MAP == 2) { const int w = n % 192; return w >= 128 ? (n - w) + 128 + ileave64(w - 128) : n; }
    return n;
}
template <int MAP> __device__ __forceinline__ void transpose_item(const float* __restrict__ W, int K, int N, bf16r* __restrict__ WT, const float* __restrict__ kscale, float* scr, int item, int lane) {
    const int nblk = N / 32, kb = item / nblk, nb = item % nblk, k0 = 64 * kb, n0 = 32 * nb;
#pragma unroll 8
    for (int i = 0; i < 32; ++i) { const int kk = 2 * i + (lane >> 5); float v = W[(size_t)(k0 + kk) * N + n0 + (lane & 31)]; if (kscale) v *= kscale[k0 + kk]; scr[kk * 33 + (lane & 31)] = v; }
    asm volatile("s_waitcnt lgkmcnt(0)" ::: "memory");
    const int c = lane & 7;
#pragma unroll
    for (int j = 0; j < 4; ++j) { const int n = (lane >> 3) + 8 * j; const float* s = scr + (8 * c) * 33 + n;
        v4u o; o.x = pk2(s[0 * 33], s[1 * 33]); o.y = pk2(s[2 * 33], s[3 * 33]); o.z = pk2(s[4 * 33], s[5 * 33]); o.w = pk2(s[6 * 33], s[7 * 33]);
        *(v4u*)(WT + (size_t)colmap<MAP>(n0 + n) * K + k0 + 8 * c) = o; }
    asm volatile("s_waitcnt lgkmcnt(0)" ::: "memory");
}
__device__ __forceinline__ void norm_mod_row(const float* __restrict__ xrow, const float* __restrict__ g, const float* __restrict__ sh, const float* __restrict__ sc, bf16r* __restrict__ orow, int lane) {
    const f32x4* xr = (const f32x4*)xrow + lane; f32x4 v[4]; float s = 0.f;
#pragma unroll
    for (int j = 0; j < 4; ++j) { v[j] = xr[64 * j]; s += (v[j][0] * v[j][0] + v[j][1] * v[j][1]) + (v[j][2] * v[j][2] + v[j][3] * v[j][3]); }
    const float rstd = rsqrtf(wave_sum(s) * (1.f / DM) + EPS);
    unsigned long long* o8 = (unsigned long long*)orow + lane;
#pragma unroll
    for (int j = 0; j < 4; ++j) { const f32x4 gg = ((const f32x4*)g)[lane + 64 * j], hh = ((const f32x4*)sh)[lane + 64 * j], cc = ((const f32x4*)sc)[lane + 64 * j];
        const f32x4 y = (v[j] * rstd * gg) * (cc + 1.f) + hh;
        o8[64 * j] = (unsigned long long)pk2(y[0], y[1]) | ((unsigned long long)pk2(y[2], y[3]) << 32); }
}

#define LAUNDER_V(x) asm volatile("" : "+v"(x))
#define LAUNDER_S(x) asm volatile("" : "+s"(x))
struct Args { const float* in[20]; float* out; unsigned char* ws; };
__global__ void __launch_bounds__(512, 2) fwd_megakernel(Args a) {
    extern __shared__ __attribute__((aligned(16))) unsigned char lds[];
    cg::grid_group grid = cg::this_grid();
    const int tid = threadIdx.x, lane = tid & 63, wave = __builtin_amdgcn_readfirstlane(tid >> 6), G = gridDim.x, bx = blockIdx.x;
    const int gw = bx * 8 + wave, NGW = G * 8;
    unsigned char* ws = a.ws;
    const float *x = a.in[0], *cvec = a.in[1], *ctx = a.in[2], *c_ctx = a.in[3], *w_ada = a.in[4], *b_ada = a.in[5], *g_attn = a.in[6], *g_ffn = a.in[7], *w_in = a.in[8],
                *dec_f = a.in[9], *dec_b = a.in[10], *g_ret = a.in[11], *g_q = a.in[12], *w_uq = a.in[13], *g_kv = a.in[14], *w_ukv = a.in[15], *w_out = a.in[16], *w_ff1 = a.in[17], *w_ff2 = a.in[18], *g_final = a.in[19];
    float* mod = (float*)(ws + WS_MOD); float* rope = (float*)(ws + WS_ROPE); float* ssq = (float*)(ws + WS_SSQ);
    bf16r *WinT = (bf16r*)(ws + WS_WIN), *WuqT = (bf16r*)(ws + WS_WUQ), *WukvT = (bf16r*)(ws + WS_WUKV), *WoutT = (bf16r*)(ws + WS_WOUT), *W1T = (bf16r*)(ws + WS_W1), *W2T = (bf16r*)(ws + WS_W2);
    bf16r *HN = (bf16r*)(ws + WS_HN), *P = (bf16r*)(ws + WS_P), *Q = (bf16r*)(ws + WS_Q), *KV = (bf16r*)(ws + WS_KV), *ST = (bf16r*)(ws + WS_ST), *HID = (bf16r*)(ws + WS_HID);
    bf16r *Y = HN, *H2 = HN;
    PG8_LAS unsigned char* ldsl = (PG8_LAS unsigned char*)lds;

#if !defined(NO_P0)
    if (bx < 96) {
        int tid = threadIdx.x, lane = tid & 63; LAUNDER_V(tid); LAUNDER_V(lane);
        float* sl = (float*)lds; float* red = (float*)(lds + 17 * 1024 * 4);
        for (int idx = tid; idx < 17 * 1024; idx += 512) { const int r = idx >> 10, k = idx & 1023; const float cv = r < 16 ? cvec[r * 1024 + k] : c_ctx[k]; sl[idx] = cv / (1.f + __expf(-cv)); }
        __syncthreads();
        const int n0 = bx * 64; float acc[17];
#pragma unroll
        for (int r = 0; r < 17; ++r) acc[r] = 0.f;
        for (int kk = 0; kk < 128; kk += 4) { const int k = wave * 128 + kk; const float* wp = w_ada + (size_t)k * 6144 + n0 + lane;
            const float w0 = wp[0], w1 = wp[6144], w2 = wp[2 * 6144], w3 = wp[3 * 6144];
#pragma unroll
            for (int r = 0; r < 17; ++r) { const f32x4 sv = *(const f32x4*)(sl + r * 1024 + k); acc[r] += (sv[0] * w0 + sv[1] * w1) + (sv[2] * w2 + sv[3] * w3); } }
#pragma unroll
        for (int r = 0; r < 17; ++r) red[(wave * 17 + r) * 64 + lane] = acc[r];
        __syncthreads();
        for (int idx = tid; idx < 17 * 64; idx += 512) { const int r = idx >> 6, l = idx & 63; float s = b_ada[n0 + l];
#pragma unroll
            for (int w = 0; w < 8; ++w) s += red[(w * 17 + r) * 64 + l];
            mod[r * 6144 + n0 + l] = s; }
        __syncthreads();
    }
    {
        int tid = threadIdx.x, lane = tid & 63; LAUNDER_V(tid); LAUNDER_V(lane);
        float* scr = (float*)(lds + wave * 16384);
        constexpr int I_IN = (DM / 64) * (NIN / 32), I_UQ = (QL / 64) * (NQ / 32), I_UKV = (KVL / 64) * (NKV / 32), I_OUT = (DM / 64) * (DM / 32), I_1 = (DM / 64) * (DFF / 32), I_2 = (DFF / 64) * (DM / 32);
        constexpr int NITEMS = I_IN + I_UQ + I_UKV + I_OUT + I_1 + I_2;
        for (int it = gw; it < NITEMS; it += NGW) {
            int r = it;
            if (r < I_IN) { transpose_item<1>(w_in, DM, NIN, WinT, nullptr, scr, r, lane); continue; } r -= I_IN;
            if (r < I_UQ) { transpose_item<2>(w_uq, QL, NQ, WuqT, g_q, scr, r, lane); continue; } r -= I_UQ;
            if (r < I_UKV) { transpose_item<0>(w_ukv, KVL, NKV, WukvT, g_kv, scr, r, lane); continue; } r -= I_UKV;
            if (r < I_OUT) { transpose_item<0>(w_out, DM, DM, WoutT, nullptr, scr, r, lane); continue; } r -= I_OUT;
            if (r < I_1) { transpose_item<0>(w_ff1, DM, DFF, W1T, nullptr, scr, r, lane); continue; } r -= I_1;
            transpose_item<0>(w_ff2, DFF, DM, W2T, nullptr, scr, r, lane);
        }
        for (int i = bx * 512 + tid; i < 64 * DM / 8; i += G * 512) ((v4u*)(WinT + (size_t)NIN * DM))[i] = (v4u){0u, 0u, 0u, 0u};
        for (int i = bx * 512 + tid; i < SEQ * 32; i += G * 512) { const int t = i >> 5, j = i & 31; const float pos = (float)(j < 16 ? (t >> 6) : (t & 63));
            const float freq = powf(10000.f, -(float)(j & 15) / 16.f); const float ang = pos * freq; rope[2 * i] = cosf(ang); rope[2 * i + 1] = sinf(ang); }
    }
#endif
    grid.sync();
    { int gw1 = gw, ln = lane; LAUNDER_S(gw1); LAUNDER_V(ln);
    for (int row = gw1; row < MALL; row += NGW) { const int b = row / TOK, j = row % TOK;
        const float* src = j < CTXL ? ctx + ((size_t)b * CTXL + j) * DM : x + ((size_t)b * SEQ + (j - CTXL)) * DM; const float* md = mod + (size_t)(j < CTXL ? 16 : b) * 6144;
        norm_mod_row(src, g_attn, md, md + 1024, HN + (size_t)row * DM, ln); } }
    grid.sync();
#if !defined(NO_GEMM)
    { pg8::Gemm g{HN, WinT, MALL, NINP, DM, DM}; pg8::StaticOrder S; S.init(MALL, NINP, G, bx);
      pg8::EpiInProj E{P, ssq, rope};
      pg8::gemm_phase<pg8::EpiInProj, pg8::StaticOrder, true, true>(ldsl, g, S, E); }
#endif
    grid.sync();
#if !defined(NO_R1)
    if (bx < 128) att::ret_states(bx, (const att::bf16*)P, (att::bf16*)ST, dec_f, dec_b, (char*)lds);
#endif
#if !defined(NO_GUQ)
    { pg8::Gemm g{P + C_CQ, WuqT, MALL, NQ, QL, NINP}; pg8::StaticOrder S; S.init(MALL, NQ, G, bx);
      pg8::EpiUpQ E{Q};
      pg8::gemm_phase<pg8::EpiUpQ, pg8::StaticOrder, true, true>(ldsl, g, S, E); }
#endif
#if !defined(NO_GUKV)
    { pg8::Gemm g{P + C_CKV, WukvT, MALL, NKV, KVL, NINP}; pg8::StaticOrder S; S.init(MALL, NKV, G, bx);
      pg8::EpiUpKV E{KV, ssq};
      pg8::gemm_phase<pg8::EpiUpKV, pg8::StaticOrder, true, true>(ldsl, g, S, E); }
#endif
    grid.sync();
#if !defined(NO_ATT)
    for (int u = bx; u < 512; u += G) { const int xcd = u & 7, idx = u >> 3, bh = xcd * 8 + (idx >> 3), qb = idx & 7, b = bh >> 2, h = bh & 3;
        const size_t krow = (size_t)b * TOK;
        att::attn_body((const att::bf16*)Q + (krow + CTXL + qb * 256) * NQ + h * 192, (const att::bf16*)KV + krow * NKV + h * 256, (const att::bf16*)KV + krow * NKV + h * 256 + 128,
                       (const att::bf16*)P + krow * NINP + C_KPE, (att::bf16*)Y + ((size_t)b * SEQ + qb * 256) * DM + 512 + h * 128, rope + (size_t)qb * 256 * 64, ssq + (krow + CTXL + qb * 256) * 24, TOK, (char*)lds); }
#endif
#if !defined(NO_R2)
    for (int u = bx; u < 1024; u += G) { const int xcd = u & 7, idx = u >> 3, bh = xcd * 8 + (idx >> 4), n = idx & 15, b = bh >> 2, h = bh & 3;
        const float l2f = -log1pf(expf(-dec_f[h])) * 1.4426950408889634f, l2b = -log1pf(expf(-dec_b[h])) * 1.4426950408889634f;
        att::ret_chunk(b, h, n, (const att::bf16*)P, (const att::bf16*)ST, g_ret, l2f, l2b, (att::bf16*)Y, (char*)lds); }
#endif
    grid.sync();
#if !defined(NO_GOUT)
    { pg8::Gemm g{Y, WoutT, MLAT, DM, DM, DM}; pg8::StaticOrder S; S.init(MLAT, DM, G, bx);
      pg8::EpiGateRes E{x, a.out, mod + 2048};
      pg8::gemm_phase<pg8::EpiGateRes, pg8::StaticOrder, true, true>(ldsl, g, S, E); }
#endif
    grid.sync();
    { int gw1 = gw, ln = lane; LAUNDER_S(gw1); LAUNDER_V(ln);
    for (int row = gw1; row < MLAT; row += NGW) { const float* md = mod + (size_t)(row / SEQ) * 6144;
        norm_mod_row(a.out + (size_t)row * DM, g_ffn, md + 3072, md + 4096, H2 + (size_t)row * DM, ln); } }
    grid.sync();
#if !defined(NO_GFF1)
    { pg8::Gemm g{H2, W1T, MLAT, DFF, DM, DM}; pg8::StaticOrder S; S.init(MLAT, DFF, G, bx);
      pg8::EpiRelu2 E{HID};
      pg8::gemm_phase<pg8::EpiRelu2, pg8::StaticOrder, true, true>(ldsl, g, S, E); }
#endif
    grid.sync();
#if !defined(NO_GFF2)
    { pg8::Gemm g{HID, W2T, MLAT, DM, DFF, DFF}; pg8::StaticOrder S; S.init(MLAT, DM, G, bx);
      pg8::EpiGateRes E{a.out, a.out, mod + 5120};
      pg8::gemm_phase<pg8::EpiGateRes, pg8::StaticOrder, true, true>(ldsl, g, S, E); }
#endif
    grid.sync();
    { int gw1 = gw, ln = lane; LAUNDER_S(gw1); LAUNDER_V(ln);
    for (int row = gw1; row < MLAT; row += NGW) { f32x4* xr = (f32x4*)(a.out + (size_t)row * DM) + ln; f32x4 v[4]; float s = 0.f;
#pragma unroll
        for (int j = 0; j < 4; ++j) { v[j] = xr[64 * j]; s += (v[j][0] * v[j][0] + v[j][1] * v[j][1]) + (v[j][2] * v[j][2] + v[j][3] * v[j][3]); }
        const float rstd = rsqrtf(wave_sum(s) * (1.f / DM) + EPS);
#pragma unroll
        for (int j = 0; j < 4; ++j) xr[64 * j] = v[j] * rstd * ((const f32x4*)g_final)[ln + 64 * j]; } }
}

extern "C" void kernel_launch(void* const* d_in, const int* in_sizes, int n_in, void* d_out, int out_size, void* d_ws, size_t ws_size, hipStream_t stream) {
    static int grid = 0;
    if (grid == 0) {
        if (n_in != 20 || in_sizes[0] != MLAT * DM || out_size != MLAT * DM || ws_size < WS_END) { fprintf(stderr, "kernel_launch: unexpected shapes / workspace (n_in %d, ws %zu)\n", n_in, ws_size); grid = -1; return; }
        int dev = 0, cus = 0, per_cu = 0;
        (void)hipGetDevice(&dev); (void)hipDeviceGetAttribute(&cus, hipDeviceAttributeMultiprocessorCount, dev);
        if (hipFuncSetAttribute((const void*)fwd_megakernel, hipFuncAttributeMaxDynamicSharedMemorySize, LDS_BYTES) != hipSuccess) { fprintf(stderr, "kernel_launch: hipFuncSetAttribute failed\n"); grid = -1; return; }
        if (hipOccupancyMaxActiveBlocksPerMultiprocessor(&per_cu, (const void*)fwd_megakernel, 512, LDS_BYTES) != hipSuccess || per_cu < 1) { fprintf(stderr, "kernel_launch: occupancy query says %d\n", per_cu); grid = -1; return; }
        grid = cus;
    }
    if (grid < 0) return;
    Args a{};
    for (int i = 0; i < 20; ++i) a.in[i] = (const float*)d_in[i];
    a.out = (float*)d_out; a.ws = (unsigned char*)d_ws;
    void* args[] = {&a};
    hipError_t e = hipLaunchCooperativeKernel((const void*)fwd_megakernel, dim3(grid), dim3(512), args, LDS_BYTES, stream);
    if (e != hipSuccess) fprintf(stderr, "cooperative launch failed: %s (grid %d)\n", hipGetErrorString(e), grid);
}
```

```cpp
#include <hip/hip_runtime.h>
#include <hip/hip_bf16.h>
#include <hip/hip_cooperative_groups.h>
#include <cstdio>
#include <cstdint>
namespace cg = cooperative_groups;

constexpr int DM = 1024, NB = 16, SEQ = 2048, CTXL = 256, TOK = SEQ + CTXL, MALL = NB * TOK, MLAT = NB * SEQ;
constexpr int NIN = 2240, NINP = 2304, DFF = 4096, QL = 384, KVL = 256, NQ = 768, NKV = 1024;
constexpr float EPS = 1e-6f;
constexpr int C_RQ = 0, C_RK = 256, C_RV = 512, C_RG = 1024, C_CQ = 1536, C_CKV = 1920, C_KPE = 2176;
constexpr size_t MiB = 1u << 20;
constexpr size_t WS_MOD = 0, WS_ROPE = MiB / 2, WS_WIN = 1 * MiB, WS_WUQ = 6 * MiB, WS_WUKV = 7 * MiB, WS_WOUT = 8 * MiB, WS_W1 = 10 * MiB, WS_W2 = 18 * MiB;
constexpr size_t WS_SSQ = 26 * MiB, WS_ST = 34 * MiB, WS_HN = 66 * MiB, WS_P = 138 * MiB, WS_Q = 300 * MiB, WS_KV = 354 * MiB, WS_CTL = 426 * MiB, CTL_BYTES = 16384, WS_END = 427 * MiB;
constexpr size_t WS_HID = WS_P;
static_assert(WS_P + (size_t)MALL * NINP * 2 <= WS_Q && WS_Q + (size_t)MALL * NQ * 2 <= WS_KV && WS_KV + (size_t)MALL * NKV * 2 <= WS_CTL && WS_HID + (size_t)MLAT * DFF * 2 <= WS_CTL, "ws map");
static_assert(WS_HN + (size_t)MALL * DM * 2 <= WS_P && WS_ST + (size_t)NB * 4 * 16 * 128 * 128 * 2 <= WS_HN && WS_SSQ + (size_t)MALL * 24 * 4 <= WS_ST, "ws map 2");
constexpr int LDS_BYTES = 147456;

#ifndef ATT_SDEPTH
#define ATT_SDEPTH 1
#endif
#ifndef ATT_NQREG
#define ATT_NQREG 12
#endif
namespace pg8 {
#define PG8_LAS __attribute__((address_space(3)))
typedef unsigned short bf16_t;
typedef short bf16x8 __attribute__((ext_vector_type(8)));
typedef float f32x4 __attribute__((ext_vector_type(4)));
typedef unsigned u32x4 __attribute__((ext_vector_type(4)));
constexpr int BM = 256, BK = 64, HALF = 128, HTB = HALF * BK * 2  , STAGE_BYTES = 8 * HTB, NXCD = 8, WGM = 8;

__host__ __device__ __forceinline__ int lds_byte(int r, int c) { const int st = (r >> 4) * 2 + (c >> 5), rr = r & 15, cc = c & 31, ob = rr * 64 + cc * 2; return st * 1024 + (ob ^ (((ob >> 9) & 1) << 5)); }
__host__ __device__ __forceinline__ void stage_rc(int b, int& R, int& C) { const int st = b / 1024, sb = b % 1024, swz = sb ^ (((sb >> 9) & 1) << 5); R = (st >> 1) * 16 + swz / 64; C = (st & 1) * 32 + (swz % 64) / 2; }
__host__ __device__ __forceinline__ int perm32(int rho) { const int n = rho >> 4, i = rho & 15; return 8 * (i >> 2) + 4 * n + (i & 3); }

struct Unit { int pm, pn; };
struct Gemm { const bf16_t* A; const bf16_t* Bt; int M, N, K, lda; };

struct StaticOrder {
    int nM, nN, nwg, G, c;
    __host__ __device__ void init(int M, int N, int G_, int c_) { nM = M / BM; nN = N / BM; nwg = nM * nN; G = G_; c = c_; }
    __host__ __device__ bool next(int i, Unit& u) const {
        const long L = (long)i * G + c; if (L >= nwg) return false;
        int wgid = (int)L; { const int q = nwg / NXCD, r = nwg % NXCD, xcd = wgid % NXCD, off = wgid / NXCD; wgid = (xcd < r ? xcd * (q + 1) : r * (q + 1) + (xcd - r) * q) + off; }
        const int nig = WGM * nN, gid = wgid / nig, fm = gid * WGM, gsz = (nM - fm) < WGM ? (nM - fm) : WGM;
        u.pm = fm + ((wgid % nig) % gsz); u.pn = (wgid % nig) / gsz; return true;
    }
    __device__ __forceinline__ void a_ready(const Unit&) const {}
    __device__ __forceinline__ void done(const Unit&) const {}
};

__device__ __forceinline__ unsigned cvt_pk_bf16(float lo, float hi) { unsigned r; asm volatile("v_cvt_pk_bf16_f32 %0, %1, %2" : "=v"(r) : "v"(lo), "v"(hi)); return r; }
typedef float f32x2 __attribute__((ext_vector_type(2)));
__device__ __forceinline__ void store8(bf16_t* p, const f32x4 v0, const f32x4 v1) {
    u32x4 w; w.x = cvt_pk_bf16(v0[0], v0[1]); w.y = cvt_pk_bf16(v0[2], v0[3]); w.z = cvt_pk_bf16(v1[0], v1[1]); w.w = cvt_pk_bf16(v1[2], v1[3]); *(u32x4*)p = w;
}
__device__ __forceinline__ void rope8(f32x4& v0, f32x4& v1, const float* cs) {
    const f32x4 a = *(const f32x4*)cs, b = *(const f32x4*)(cs + 4); f32x4 o0, o1;
    o0[0] = v0[0] * a[0] - v0[1] * a[1]; o0[1] = v0[1] * a[0] + v0[0] * a[1]; o0[2] = v0[2] * a[2] - v0[3] * a[3]; o0[3] = v0[3] * a[2] + v0[2] * a[3];
    o1[0] = v1[0] * b[0] - v1[1] * b[1]; o1[1] = v1[1] * b[0] + v1[0] * b[1]; o1[2] = v1[2] * b[2] - v1[3] * b[3]; o1[3] = v1[3] * b[2] + v1[2] * b[3];
    v0 = o0; v1 = o1;
}
__device__ __forceinline__ float dot4(const f32x4 a) { return (a[0] * a[0] + a[1] * a[1]) + (a[2] * a[2] + a[3] * a[3]); }
struct EpiInProj {
    static constexpr bool PERM = true, AFTER_DRAIN = false;
    bf16_t* P; float* ssq; const float* rope;
    __device__ __forceinline__ void operator()(const f32x4 (&acc)[2][2][4][2], const Unit& u, int wr, int wc, int fr, int fq) const {
        const int pmw = u.pm % 9; const bool latent = pmw != 0;
        const int trow0 = (pmw - 1) * 256 + wr * 64 + fr, row0 = u.pm * BM + wr * 64 + fr;
#pragma unroll
        for (int bj = 0; bj < 2; ++bj) {
            const int seg = u.pn * 2 + bj, col0 = u.pn * BM + bj * HALF + wc * 32 + 8 * fq;
            int kind;
            if (seg < 2) kind = 1; else if (seg < 4) kind = 2; else if (seg < 12) kind = 0; else if (seg < 17) kind = 3; else kind = (wc < 2) ? 1 : 4;
            if (kind != 4) {
                const float sc = (kind == 2) ? 0.125f : 1.f; const bool dorope = latent && (kind == 1 || kind == 2);
                const int i0 = (col0 & 63) >> 1, slot = (u.pn - 6) * 8 + bj * 4 + wc;
#pragma unroll
                for (int ai = 0; ai < 2; ++ai)
#pragma unroll
                    for (int m = 0; m < 4; ++m) {
                        f32x4 v0 = acc[ai][bj][m][0] * sc, v1 = acc[ai][bj][m][1] * sc; const int roff = ai * HALF + m * 16;
                        if (dorope) rope8(v0, v1, rope + ((size_t)(trow0 + roff) * 32 + i0) * 2);
                        if (kind == 3) { float s = dot4(v0) + dot4(v1); s += __shfl_xor(s, 16); s += __shfl_xor(s, 32); if (fq == 0) ssq[(size_t)(row0 + roff) * 24 + slot] = s; }
                        store8(P + (size_t)(row0 + roff) * NINP + col0, v0, v1);
                    }
            }
        }
    }
};
struct EpiUpQ {
    static constexpr bool PERM = true, AFTER_DRAIN = false;
    bf16_t* Q;
    __device__ __forceinline__ void operator()(const f32x4 (&acc)[2][2][4][2], const Unit& u, int wr, int wc, int fr, int fq) const {
        const int row0 = u.pm * BM + wr * 64 + fr;
#pragma unroll
        for (int bj = 0; bj < 2; ++bj) {
            const int col0 = u.pn * BM + bj * HALF + wc * 32 + 8 * fq;
#pragma unroll
            for (int ai = 0; ai < 2; ++ai)
#pragma unroll
                for (int m = 0; m < 4; ++m) store8(Q + (size_t)(row0 + ai * HALF + m * 16) * NQ + col0, acc[ai][bj][m][0], acc[ai][bj][m][1]);
        }
    }
};
struct EpiUpKV {
    static constexpr bool PERM = true, AFTER_DRAIN = false;
    bf16_t* KV; const float* ssq;
    __device__ __forceinline__ void operator()(const f32x4 (&acc)[2][2][4][2], const Unit& u, int wr, int wc, int fr, int fq) const {
        const int row0 = u.pm * BM + wr * 64 + fr;
#pragma unroll
        for (int ai = 0; ai < 2; ++ai)
#pragma unroll
            for (int m = 0; m < 4; ++m) { const int roff = ai * HALF + m * 16;
                const float* s = ssq + (size_t)(row0 + roff) * 24 + 12; const f32x4 a = *(const f32x4*)s, b = *(const f32x4*)(s + 4);
                const float t = ((a[0] + a[1]) + (a[2] + a[3])) + ((b[0] + b[1]) + (b[2] + b[3])); const float rs = rsqrtf(t * (1.f / KVL) + EPS);
#pragma unroll
                for (int bj = 0; bj < 2; ++bj) { const int col0 = u.pn * BM + bj * HALF + wc * 32 + 8 * fq;
                    store8(KV + (size_t)(row0 + roff) * NKV + col0, acc[ai][bj][m][0] * rs, acc[ai][bj][m][1] * rs); }
                asm volatile("" ::: "memory"); }
    }
};
struct EpiGateRes {
    static constexpr bool PERM = true, AFTER_DRAIN = false;
    const float* base; float* out; const float* gate;
    __device__ __forceinline__ void operator()(const f32x4 (&acc)[2][2][4][2], const Unit& u, int wr, int wc, int fr, int fq) const {
        const int row0 = u.pm * BM + wr * 64 + fr, b = u.pm >> 3;
#pragma unroll
        for (int bj = 0; bj < 2; ++bj) {
            const int col0 = u.pn * BM + bj * HALF + wc * 32 + 8 * fq;
            const f32x4 g0 = *(const f32x4*)(gate + (size_t)b * 6144 + col0), g1 = *(const f32x4*)(gate + (size_t)b * 6144 + col0 + 4);
#pragma unroll
            for (int ai = 0; ai < 2; ++ai)
#pragma unroll
                for (int m = 0; m < 4; ++m) { const size_t off = (size_t)(row0 + ai * HALF + m * 16) * DM + col0;
                    const f32x4 x0 = *(const f32x4*)(base + off), x1 = *(const f32x4*)(base + off + 4);
                    *(f32x4*)(out + off) = x0 + g0 * acc[ai][bj][m][0]; *(f32x4*)(out + off + 4) = x1 + g1 * acc[ai][bj][m][1]; }
        }
    }
};
struct EpiRelu2 {
    static constexpr bool PERM = true, AFTER_DRAIN = false;
    bf16_t* H;
    __device__ __forceinline__ void operator()(const f32x4 (&acc)[2][2][4][2], const Unit& u, int wr, int wc, int fr, int fq) const {
        const int row0 = u.pm * BM + wr * 64 + fr;
#pragma unroll
        for (int bj = 0; bj < 2; ++bj) {
            const int col0 = u.pn * BM + bj * HALF + wc * 32 + 8 * fq;
#pragma unroll
            for (int ai = 0; ai < 2; ++ai)
#pragma unroll
                for (int m = 0; m < 4; ++m) { f32x4 v0 = acc[ai][bj][m][0], v1 = acc[ai][bj][m][1];
#pragma unroll
                    for (int e = 0; e < 4; ++e) { const float a = fmaxf(v0[e], 0.f), c = fmaxf(v1[e], 0.f); v0[e] = a * a; v1[e] = c * c; }
                    store8(H + (size_t)(row0 + ai * HALF + m * 16) * DFF + col0, v0, v1); }
        }
    }
};
template <class Epi, class Sched, bool ALIGN_EPI = false, bool SP2 = false>
__device__ __forceinline__ void gemm_phase(PG8_LAS unsigned char* lds, const Gemm g, const Sched& S, const Epi& E) {
    int tid_ = threadIdx.x; asm volatile("" : "+v"(tid_));
    const int tid = tid_, wid = __builtin_amdgcn_readfirstlane(tid >> 6), lane = tid & 63, wr = wid >> 2, wc = wid & 3, fr = lane & 15, fq = lane >> 4;
    const int K = g.K, nt = K / BK;
    unsigned voffA[2], voffB[2];
#pragma unroll
    for (int i = 0; i < 2; ++i) { int R, C; stage_rc(tid * 16 + i * 8192, R, C); const int Rb = Epi::PERM ? ((R & ~31) + perm32(R & 31)) : R;
        voffA[i] = (unsigned)(R * g.lda + C) * 2u; voffB[i] = (unsigned)(Rb * K + C) * 2u; }
    const size_t kstep = (size_t)(BK * 2);
    const size_t hstepA = (size_t)HALF * g.lda * 2, hstepB = (size_t)HALF * K * 2;
    const size_t tstepA = 2 * hstepA, tstepB = 2 * hstepB;
    const unsigned ldsw = (unsigned)wid * 1024u;
    const int aoff = lds_byte(wr * 64 + fr, fq * 8), boff = lds_byte(wc * 32 + fr, fq * 8);
#define PG8_SA(b, h) (((b) * 2 + (h)) * HTB)
#define PG8_SB(b, h) ((4 + (b) * 2 + (h)) * HTB)
#define PG8_STAGE(bufoff, gbase, voff) do { _Pragma("unroll") for (int _i = 0; _i < 2; ++_i) \
        __builtin_amdgcn_global_load_lds((const unsigned*)((const char*)(gbase) + (voff)[_i]), (PG8_LAS unsigned*)(lds + (bufoff) + ldsw + _i * 8192), 16, 0, 0); } while (0)
#define PG8_LDA(dst, b, h) do { _Pragma("unroll") for (int m = 0; m < 4; ++m) _Pragma("unroll") for (int k = 0; k < 2; ++k) dst[m][k] = *(const PG8_LAS bf16x8*)(lds + PG8_SA(b, h) + aoff + m * 2048 + k * 1024); } while (0)
#define PG8_LDB(dst, b, h) do { _Pragma("unroll") for (int n = 0; n < 2; ++n) _Pragma("unroll") for (int k = 0; k < 2; ++k) dst[n][k] = *(const PG8_LAS bf16x8*)(lds + PG8_SB(b, h) + boff + n * 2048 + k * 1024); } while (0)
#define PG8_MMA(ai, bj, At, Bt) do { __builtin_amdgcn_s_setprio(1); _Pragma("unroll") for (int m = 0; m < 4; ++m) _Pragma("unroll") for (int n = 0; n < 2; ++n) _Pragma("unroll") for (int k = 0; k < 2; ++k) \
        acc[ai][bj][m][n] = __builtin_amdgcn_mfma_f32_16x16x32_bf16(Bt[n][k], At[m][k], acc[ai][bj][m][n], 0, 0, 0); __builtin_amdgcn_s_setprio(0); } while (0)
#define PG8_WAIT_V(n) asm volatile("s_waitcnt vmcnt(" #n ")" ::: "memory")
#define PG8_WAIT_L(n) asm volatile("s_waitcnt lgkmcnt(" #n ")" ::: "memory")
#define PG8_BAR __builtin_amdgcn_s_barrier()
#define PG8_SCHED __builtin_amdgcn_sched_barrier(0)
    Unit cur, nxt; int ui = 0;
    if (!S.next(0, cur)) return;
    f32x4 acc[2][2][4][2];
#pragma unroll
    for (int a = 0; a < 2; ++a)
#pragma unroll
        for (int b = 0; b < 2; ++b)
#pragma unroll
            for (int m = 0; m < 4; ++m)
#pragma unroll
                for (int n = 0; n < 2; ++n) acc[a][b][m][n] = (f32x4){0.f, 0.f, 0.f, 0.f};
    bf16x8 At[4][2], B0[2][2], B1[2][2];
    const char* cA = (const char*)g.A + (size_t)cur.pm * tstepA; const char* cB = (const char*)g.Bt + (size_t)cur.pn * tstepB;
    S.a_ready(cur);
    if constexpr (SP2) {
        PG8_STAGE(PG8_SB(0, 0), cB, voffB); PG8_STAGE(PG8_SB(0, 1), cB + hstepB, voffB); PG8_STAGE(PG8_SA(0, 0), cA, voffA); PG8_STAGE(PG8_SA(0, 1), cA + hstepA, voffA);
        if (wr == 1) PG8_BAR;
        PG8_WAIT_V(2); PG8_BAR;
        PG8_STAGE(PG8_SB(1, 0), cB + kstep, voffB); PG8_STAGE(PG8_SA(1, 0), cA + kstep, voffA); PG8_STAGE(PG8_SB(1, 1), cB + hstepB + kstep, voffB);
        PG8_WAIT_V(6); PG8_BAR;
    } else {
        PG8_STAGE(PG8_SB(0, 0), cB, voffB); PG8_STAGE(PG8_SA(0, 0), cA, voffA); PG8_STAGE(PG8_SB(0, 1), cB + hstepB, voffB); PG8_STAGE(PG8_SA(0, 1), cA + hstepA, voffA);
        if (wr == 1) PG8_BAR;
        PG8_WAIT_V(4); PG8_BAR;
        PG8_STAGE(PG8_SB(1, 0), cB + kstep, voffB); PG8_STAGE(PG8_SA(1, 0), cA + kstep, voffA); PG8_STAGE(PG8_SB(1, 1), cB + hstepB + kstep, voffB);
        PG8_WAIT_V(6); PG8_BAR;
    }
    for (;;) {
        const bool has_next = S.next(ui + 1, nxt);
        const char* nA = has_next ? (const char*)g.A + (size_t)nxt.pm * tstepA : cA; const char* nB = has_next ? (const char*)g.Bt + (size_t)nxt.pn * tstepB : cB;
#pragma nounroll
        for (int t = 0; t < nt; t += 2) {
            const bool last = (t == nt - 2);
            const char* a1 = cA + (size_t)(t + 1) * kstep;
            const char* a2 = last ? nA : cA + (size_t)(t + 2) * kstep; const char* b2 = last ? nB : cB + (size_t)(t + 2) * kstep;
            const char* a3 = a2 + kstep; const char* b3 = b2 + kstep;
            if (last && has_next) S.a_ready(nxt);
            if constexpr (SP2) {
            PG8_LDB(B0, 0, 0); PG8_LDB(B1, 0, 1); PG8_SCHED; PG8_LDA(At, 0, 0); PG8_STAGE(PG8_SA(1, 1), a1 + hstepA, voffA);
            PG8_WAIT_V(8); PG8_WAIT_L(0); PG8_BAR; PG8_MMA(0, 0, At, B0); PG8_MMA(0, 1, At, B1); PG8_BAR; PG8_SCHED;
            PG8_LDA(At, 0, 1); PG8_STAGE(PG8_SB(0, 0), b2, voffB); PG8_STAGE(PG8_SB(0, 1), b2 + hstepB, voffB); PG8_STAGE(PG8_SA(0, 0), a2, voffA);
            PG8_WAIT_V(8); PG8_WAIT_L(0); PG8_BAR; PG8_MMA(1, 0, At, B0); PG8_MMA(1, 1, At, B1); PG8_BAR; PG8_SCHED;
            PG8_LDB(B0, 1, 0); PG8_LDB(B1, 1, 1); PG8_SCHED; PG8_LDA(At, 1, 0); PG8_STAGE(PG8_SA(0, 1), a2 + hstepA, voffA);
            PG8_WAIT_V(8); PG8_WAIT_L(0); PG8_BAR; PG8_MMA(0, 0, At, B0); PG8_MMA(0, 1, At, B1); PG8_BAR; PG8_SCHED;
            PG8_LDA(At, 1, 1); PG8_STAGE(PG8_SB(1, 0), b3, voffB); PG8_STAGE(PG8_SB(1, 1), b3 + hstepB, voffB); PG8_STAGE(PG8_SA(1, 0), a3, voffA);
            PG8_WAIT_V(8); PG8_WAIT_L(0); PG8_BAR; PG8_MMA(1, 0, At, B0); PG8_MMA(1, 1, At, B1); PG8_BAR; PG8_SCHED;
            } else {
            PG8_LDB(B0, 0, 0); PG8_SCHED; PG8_LDA(At, 0, 0); PG8_STAGE(PG8_SA(1, 1), a1 + hstepA, voffA);
            PG8_WAIT_L(8); PG8_BAR; PG8_WAIT_L(0); PG8_MMA(0, 0, At, B0); PG8_BAR; PG8_SCHED;
            PG8_LDB(B1, 0, 1); PG8_STAGE(PG8_SB(0, 0), b2, voffB);
            PG8_BAR; PG8_WAIT_L(0); PG8_MMA(0, 1, At, B1); PG8_BAR;
            PG8_LDA(At, 0, 1); PG8_STAGE(PG8_SA(0, 0), a2, voffA);
            PG8_BAR; PG8_WAIT_L(0); PG8_MMA(1, 0, At, B0); PG8_BAR; PG8_SCHED;
            PG8_STAGE(PG8_SB(0, 1), b2 + hstepB, voffB);
            PG8_WAIT_V(6); PG8_BAR; PG8_MMA(1, 1, At, B1); PG8_BAR;
            PG8_LDB(B0, 1, 0); PG8_SCHED; PG8_LDA(At, 1, 0); PG8_STAGE(PG8_SA(0, 1), a2 + hstepA, voffA);
            PG8_WAIT_L(8); PG8_BAR; PG8_WAIT_L(0); PG8_MMA(0, 0, At, B0); PG8_BAR; PG8_SCHED;
            PG8_LDB(B1, 1, 1); PG8_STAGE(PG8_SB(1, 0), b3, voffB);
            PG8_BAR; PG8_WAIT_L(0); PG8_MMA(0, 1, At, B1); PG8_BAR;
            PG8_LDA(At, 1, 1); PG8_STAGE(PG8_SA(1, 0), a3, voffA);
            PG8_BAR; PG8_WAIT_L(0); PG8_MMA(1, 0, At, B0); PG8_BAR; PG8_SCHED;
            PG8_STAGE(PG8_SB(1, 1), b3 + hstepB, voffB);
            PG8_WAIT_V(6); PG8_BAR; PG8_MMA(1, 1, At, B1); PG8_BAR;
            }
        }
        if constexpr (ALIGN_EPI) { if (wr == 0) PG8_BAR; }
        if constexpr (!Epi::AFTER_DRAIN) { E(acc, cur, wr, wc, fr, fq); S.done(cur); }
        if (!has_next) break;
#pragma unroll
        for (int a = 0; a < 2; ++a)
#pragma unroll
            for (int b = 0; b < 2; ++b)
#pragma unroll
                for (int m = 0; m < 4; ++m)
#pragma unroll
                    for (int n = 0; n < 2; ++n) acc[a][b][m][n] = (f32x4){0.f, 0.f, 0.f, 0.f};
        cur = nxt; cA = nA; cB = nB; ++ui;
        if constexpr (ALIGN_EPI) { if (wr == 1) PG8_BAR; }
    }
    PG8_WAIT_V(0);
    if constexpr (!ALIGN_EPI) { if (wr == 0) PG8_BAR; }
    PG8_BAR;
    if constexpr (Epi::AFTER_DRAIN) { E.fused(acc, cur, wr, wc, fr, fq, lds, wid, lane); S.done(cur); }
#undef PG8_SA
#undef PG8_SB
#undef PG8_STAGE
#undef PG8_LDA
#undef PG8_LDB
#undef PG8_MMA
#undef PG8_WAIT_V
#undef PG8_WAIT_L
#undef PG8_BAR
#undef PG8_SCHED
}
}
namespace att {
using bf16 = __hip_bfloat16;
using bf16x8 = __attribute__((ext_vector_type(8))) short;
using s16x4  = __attribute__((ext_vector_type(4))) short;
using f32x16 = __attribute__((ext_vector_type(16))) float;
using u32x4  = __attribute__((ext_vector_type(4))) unsigned;
using f32x4  = __attribute__((ext_vector_type(4))) float;
constexpr int NW = 8, QBLK = 32, KVBLK = 64;
constexpr float SCALE = 0.07216878364870323f;
constexpr float THR = 8.f;
constexpr int SDEPTH = ATT_SDEPTH;
constexpr int SHM_V = 16384, SHM_K = 24576;
constexpr int LDQ = NQ, LDK = NKV, LDP = NINP, LDO = DM;
constexpr int SHM_ATTN = 2 * SHM_V + 2 * SHM_K + NW * 64 * 4;
#define KSWZ(row, colB) ((row) * 384 + ((colB) ^ (((row) & 7) << 4)))
#define SBAR() __builtin_amdgcn_sched_barrier(0)
__device__ __forceinline__ int crow(int r, int hi) { return (r & 3) + 8 * (r >> 2) + 4 * hi; }
__device__ __forceinline__ unsigned cvtpk(float lo, float hi) { unsigned r; asm volatile("v_cvt_pk_bf16_f32 %0, %1, %2" : "=v"(r) : "v"(lo), "v"(hi)); return r; }
__device__ __forceinline__ float bf2f(short s) { return __uint_as_float(((unsigned)(unsigned short)s) << 16); }
__device__ __forceinline__ bf16x8 ld8(const bf16* p) { return *reinterpret_cast<const bf16x8*>(p); }
__device__ __forceinline__ bf16x8 scale8(bf16x8 v, float s) {
  u32x4 w = {cvtpk(bf2f(v[0]) * s, bf2f(v[1]) * s), cvtpk(bf2f(v[2]) * s, bf2f(v[3]) * s), cvtpk(bf2f(v[4]) * s, bf2f(v[5]) * s), cvtpk(bf2f(v[6]) * s, bf2f(v[7]) * s)};
  return *reinterpret_cast<bf16x8*>(&w);
}

__device__ __forceinline__ void partialSM(f32x16& p0, f32x16& p1, float& m_reg, float& mn, float& alpha) {
  constexpr float C = SCALE * 1.4426950408889634f;
  float pmax = p0[0]; for (int r = 1; r < 16; ++r) pmax = fmaxf(pmax, p0[r]); for (int r = 0; r < 16; ++r) pmax = fmaxf(pmax, p1[r]);
  { auto rr = __builtin_amdgcn_permlane32_swap(__float_as_uint(pmax), __float_as_uint(pmax), false, false);
    pmax = fmaxf(__uint_as_float(rr[0]), __uint_as_float(rr[1])); }
  if (__builtin_expect(__all(pmax - m_reg <= THR / SCALE), 1)) { mn = m_reg; alpha = 1.f; }
  else { mn = fmaxf(m_reg, pmax); alpha = __builtin_amdgcn_exp2f((m_reg - mn) * C); m_reg = mn; }
  float mnC = -mn * C;
  for (int r = 0; r < 16; ++r) p0[r] = fmaf(p0[r], C, mnC); for (int r = 0; r < 16; ++r) p1[r] = fmaf(p1[r], C, mnC);
  for (int r = 0; r < 16; ++r) p0[r] = __builtin_amdgcn_exp2f(p0[r]);
}
#define PK4(P, BASE, OUT) do { unsigned a0 = cvtpk(P[BASE + 0], P[BASE + 1]), a1 = cvtpk(P[BASE + 2], P[BASE + 3]);   \
    unsigned b0 = cvtpk(P[BASE + 4], P[BASE + 5]), b1 = cvtpk(P[BASE + 6], P[BASE + 7]);                              \
    auto r0 = __builtin_amdgcn_permlane32_swap(a0, b0, false, false); auto r1 = __builtin_amdgcn_permlane32_swap(a1, b1, false, false); \
    u32x4 w = {r0[0], r1[0], r0[1], r1[1]}; OUT = *reinterpret_cast<bf16x8*>(&w); } while (0)
__device__ __forceinline__ void finishSM(f32x16& p0, f32x16& p1, float alpha, float& l_reg, bf16x8& pa0, bf16x8& pa1, bf16x8& pa2, bf16x8& pa3) {
  for (int r = 0; r < 16; ++r) p1[r] = __builtin_amdgcn_exp2f(p1[r]);
  float ps = 0; for (int r = 0; r < 16; ++r) ps += p0[r]; for (int r = 0; r < 16; ++r) ps += p1[r];
  { auto rr = __builtin_amdgcn_permlane32_swap(__float_as_uint(ps), __float_as_uint(ps), false, false);
    ps = __uint_as_float(rr[0]) + __uint_as_float(rr[1]); }
  l_reg = l_reg * alpha + ps;
  PK4(p0, 0, pa0); PK4(p0, 8, pa1); PK4(p1, 0, pa2); PK4(p1, 8, pa3);
}
__device__ __forceinline__ void qkt(f32x16& p0, f32x16& p1, const bf16* Ks, const bf16x8* qr, int r32, int hi) {
  p0 = f32x16{}; p1 = f32x16{};
#pragma unroll
  for (int d0 = 0; d0 < 12; ++d0) { int cb = (d0 * 16 + hi * 8) * 2;
    bf16x8 b0 = *reinterpret_cast<const bf16x8*>((const char*)Ks + KSWZ(r32, cb));
    bf16x8 b1 = *reinterpret_cast<const bf16x8*>((const char*)Ks + KSWZ(32 + r32, cb));
    p0 = __builtin_amdgcn_mfma_f32_32x32x16_bf16(b0, qr[d0], p0, 0, 0, 0);
    p1 = __builtin_amdgcn_mfma_f32_32x32x16_bf16(b1, qr[d0], p1, 0, 0, 0); }
}
__device__ __forceinline__ int v_st(int k, int c) { const int kk = (k & ~0xC) | ((k & 4) << 1) | ((k & 8) >> 1); return ((kk >> 3) * 4 + (c >> 5)) * 512 + ((kk & 7) * 32 + (c & 31)) * 2; }
__device__ __forceinline__ int v_rd_base(int lane) { return ((lane & 3) << 3) | (((lane >> 2) & 3) << 6) | (((lane >> 4) & 1) << 5) | (((lane >> 5) & 1) << 8); }
constexpr int v_rd_off(int d0, int ks, int half) { return d0 * 512 + ks * 4096 + half * 2048; }
template <int OFF> __device__ __forceinline__ s16x4 tr_read(int vb) {
  s16x4 r; asm volatile("ds_read_b64_tr_b16 %0, %1 offset:%2" : "=&v"(r) : "v"(vb), "i"(OFF) : "memory"); return r;
}
#define PKF(L, H) (bf16x8){L[0], L[1], L[2], L[3], H[0], H[1], H[2], H[3]}
template <int D0> __device__ __forceinline__ void pv_one(f32x16& od, int vb, bf16x8 pa0, bf16x8 pa1, bf16x8 pa2, bf16x8 pa3) {
  const s16x4 l0 = tr_read<v_rd_off(D0, 0, 0)>(vb), h0 = tr_read<v_rd_off(D0, 0, 1)>(vb), l1 = tr_read<v_rd_off(D0, 1, 0)>(vb), h1 = tr_read<v_rd_off(D0, 1, 1)>(vb);
  const s16x4 l2 = tr_read<v_rd_off(D0, 2, 0)>(vb), h2 = tr_read<v_rd_off(D0, 2, 1)>(vb), l3 = tr_read<v_rd_off(D0, 3, 0)>(vb), h3 = tr_read<v_rd_off(D0, 3, 1)>(vb);
  asm volatile("s_waitcnt lgkmcnt(0)" ::: "memory"); SBAR();
  od = __builtin_amdgcn_mfma_f32_32x32x16_bf16(pa0, PKF(l0, h0), od, 0, 0, 0);
  od = __builtin_amdgcn_mfma_f32_32x32x16_bf16(pa1, PKF(l1, h1), od, 0, 0, 0);
  od = __builtin_amdgcn_mfma_f32_32x32x16_bf16(pa2, PKF(l2, h2), od, 0, 0, 0);
  od = __builtin_amdgcn_mfma_f32_32x32x16_bf16(pa3, PKF(l3, h3), od, 0, 0, 0);
}
__device__ __forceinline__ void pv_d0(f32x16* o, int vb, bf16x8 pa0, bf16x8 pa1, bf16x8 pa2, bf16x8 pa3) {
  pv_one<0>(o[0], vb, pa0, pa1, pa2, pa3); pv_one<1>(o[1], vb, pa0, pa1, pa2, pa3); pv_one<2>(o[2], vb, pa0, pa1, pa2, pa3); pv_one<3>(o[3], vb, pa0, pa1, pa2, pa3);
}
__device__ __forceinline__ void attn_body(const bf16* __restrict__ Qb, const bf16* __restrict__ Kh, const bf16* __restrict__ Vh, const bf16* __restrict__ Pe,
                                          bf16* __restrict__ Ob, const float* __restrict__ ropeq, const float* __restrict__ ssqq, int seq, char* lds) {
  int tid_ = threadIdx.x; asm volatile("" : "+v"(tid_));
  const int tid = tid_, wid = tid >> 6, lane = tid & 63, r32 = lane & 31, hi = lane >> 5;
  bf16* V_lds = (bf16*)lds; bf16* K_lds = (bf16*)(lds + 2 * SHM_V);
  float* ws = (float*)(lds + 2 * SHM_V + 2 * SHM_K) + wid * 64; float* li_l = ws; float* al_l = ws + 32;
  float m_reg = -1e30f, l_reg = 0; f32x16 o[4] = {}; bf16x8 qr[12];
  const bf16* Qw = Qb + (long)(wid * QBLK + r32) * LDQ + hi * 8;
  float qrs; { const float* s = ssqq + (long)(wid * QBLK + r32) * 24; const f32x4 a = *(const f32x4*)s, b = *(const f32x4*)(s + 4), c = *(const f32x4*)(s + 8);
    qrs = rsqrtf((((a[0] + a[1]) + (a[2] + a[3])) + ((b[0] + b[1]) + (b[2] + b[3])) + ((c[0] + c[1]) + (c[2] + c[3]))) * (1.f / QL) + EPS); }
#pragma unroll
  for (int d0 = 0; d0 < 8; ++d0) qr[d0] = scale8(ld8(Qw + d0 * 16), qrs);
  { const float* rp = ropeq + ((long)(wid * QBLK + r32) * 32 + hi * 4) * 2;
#pragma unroll
    for (int d0 = 0; d0 < 4; ++d0) { const bf16x8 raw = ld8(Qw + (8 + d0) * 16); const f32x4 ca = *(const f32x4*)(rp + d0 * 16), cb_ = *(const f32x4*)(rp + d0 * 16 + 4);
      const float x0 = bf2f(raw[0]) * qrs, x1 = bf2f(raw[1]) * qrs, x2 = bf2f(raw[2]) * qrs, x3 = bf2f(raw[3]) * qrs, x4 = bf2f(raw[4]) * qrs, x5 = bf2f(raw[5]) * qrs, x6 = bf2f(raw[6]) * qrs, x7 = bf2f(raw[7]) * qrs;
      u32x4 w = {cvtpk(x0 * ca[0] - x1 * ca[1], x1 * ca[0] + x0 * ca[1]), cvtpk(x2 * ca[2] - x3 * ca[3], x3 * ca[2] + x2 * ca[3]),
                 cvtpk(x4 * cb_[0] - x5 * cb_[1], x5 * cb_[0] + x4 * cb_[1]), cvtpk(x6 * cb_[2] - x7 * cb_[3], x7 * cb_[2] + x6 * cb_[3])};
      qr[8 + d0] = *reinterpret_cast<bf16x8*>(&w); } }
  const int sr = tid >> 4, sc = (tid & 15) * 8, vst0 = v_st(sr, sc), vst1 = v_st(32 + sr, sc);
  const int pr = tid >> 3, pc = (tid & 7) * 8;
  const int vb0 = (int)(uintptr_t)V_lds + v_rd_base(lane);
  bf16x8 vs0, vs1, ks0, ks1, kp;
#define SLOAD(k0) do { vs0 = ld8(&Vh[(long)((k0) + sr) * LDK + sc]); vs1 = ld8(&Vh[(long)((k0) + 32 + sr) * LDK + sc]); \
    ks0 = ld8(&Kh[(long)((k0) + sr) * LDK + sc]); ks1 = ld8(&Kh[(long)((k0) + 32 + sr) * LDK + sc]); kp = ld8(&Pe[(long)((k0) + pr) * LDP + pc]); } while (0)
#define SWRITE(b) do { *(bf16x8*)((char*)V_lds + (b) * SHM_V + vst0) = vs0; *(bf16x8*)((char*)V_lds + (b) * SHM_V + vst1) = vs1; const int kc = sc * 2; \
    *(bf16x8*)((char*)K_lds + (b) * SHM_K + KSWZ(sr, kc)) = ks0; *(bf16x8*)((char*)K_lds + (b) * SHM_K + KSWZ(32 + sr, kc)) = ks1;                  \
    *(bf16x8*)((char*)K_lds + (b) * SHM_K + KSWZ(pr, 256 + pc * 2)) = kp; } while (0)
#define RESC(a) do { if (__any((a) < 1.f)) { if (hi == 0) al_l[r32] = (a); asm volatile("s_waitcnt lgkmcnt(0)" ::: "memory"); \
    for (int d = 0; d < 4; ++d) for (int r = 0; r < 16; ++r) o[d][r] *= al_l[crow(r, hi)]; } } while (0)
  const int NT = seq / KVBLK;
  SLOAD(0); asm volatile("s_waitcnt vmcnt(0)" ::: "memory"); SWRITE(0); SLOAD(KVBLK); __syncthreads();
  for (int j = 0; j < NT; ++j) {
    const int bs = j & 1;
    f32x16 p0, p1; float mn, al; bf16x8 pa0, pa1, pa2, pa3;
    qkt(p0, p1, (const bf16*)((const char*)K_lds + bs * SHM_K), qr, r32, hi);
    partialSM(p0, p1, m_reg, mn, al);
    RESC(al);
    finishSM(p0, p1, al, l_reg, pa0, pa1, pa2, pa3); SBAR();
    pv_d0(o, vb0 + bs * SHM_V, pa0, pa1, pa2, pa3);
    if (j + 1 < NT) { SWRITE(bs ^ 1); if (j + 2 < NT) SLOAD((j + 2) * KVBLK); }
    __syncthreads();
  }
  if (hi == 0) li_l[r32] = l_reg; asm volatile("s_waitcnt lgkmcnt(0)" ::: "memory");
  float rli[16];
#pragma unroll
  for (int r = 0; r < 16; ++r) rli[r] = __builtin_amdgcn_rcpf(li_l[crow(r, hi)]);
  bf16* Ow = Ob + (long)(wid * QBLK) * LDO;
#pragma unroll
  for (int r = 0; r < 16; ++r) { int orow = crow(r, hi);
    for (int d0 = 0; d0 < 4; ++d0) Ow[(long)orow * LDO + d0 * 32 + r32] = __float2bfloat16(o[d0][r] * rli[r]); }
#undef SLOAD
#undef SWRITE
#undef RESC
}

__device__ __forceinline__ void ret_states(int item, const bf16* __restrict__ P, bf16* __restrict__ St, const float* dec_f, const float* dec_b, char* lds) {
  int tid_ = threadIdx.x; asm volatile("" : "+v"(tid_));
  const int tid = tid_, wid = tid >> 6, lane = tid & 63, r32 = lane & 31, hi = lane >> 5;
  const int b = item >> 3, h = (item >> 1) & 3, dir = item & 1;
  const float dl = (dir ? dec_b : dec_f)[h];
  const float l2 = -log1pf(expf(-dl)) * 1.4426950408889634f;
  const float decay128 = exp2f(l2 * 128.f);
  char* Kimg = lds; char* Vimg = lds + 32768;
  const int db = wid & 1, vbk = wid >> 1;
  f32x16 acc = {};
  bf16x8 kreg[2], vreg[4]; int koff[2], voff[4]; float kw[2];
#pragma unroll
  for (int q = 0; q < 2; ++q) { const int c = tid + 512 * q, row = c >> 3, col = (c & 7) * 8; koff[q] = (row >> 6) * 16384 + v_st(row & 63, col); kw[q] = exp2f(l2 * (float)(dir ? row : 127 - row)); }
#pragma unroll
  for (int q = 0; q < 4; ++q) { const int c = tid + 512 * q, row = c >> 4, col = (c & 15) * 8; voff[q] = (row >> 6) * 16384 + v_st(row & 63, col); }
  const int ka = (int)(uintptr_t)Kimg + v_rd_base(lane) + db * 512, va = (int)(uintptr_t)Vimg + v_rd_base(lane) + vbk * 512;
#define R1_ROWBASE(s) (b * TOK + (dir == 0 ? ((s) < 2 ? (s) * 128 : 256 + ((s) - 2) * 128) : ((s) < 2 ? (1 - (s)) * 128 : 256 + (17 - (s)) * 128)))
#define R1_LOAD(s) do { const long rb = R1_ROWBASE(s); \
    _Pragma("unroll") for (int q = 0; q < 2; ++q) { const int c = tid + 512 * q; kreg[q] = ld8(P + (rb + (c >> 3)) * LDP + C_RK + h * 64 + (c & 7) * 8); } \
    _Pragma("unroll") for (int q = 0; q < 4; ++q) { const int c = tid + 512 * q; vreg[q] = ld8(P + (rb + (c >> 4)) * LDP + C_RV + h * 128 + (c & 15) * 8); } } while (0)
#define R1_STORE(n) do { bf16* dst = St + ((long)((b * 4 + h) * 16 + (n)) * 128 + dir * 64 + db * 32) * 128 + vbk * 32 + r32; \
    _Pragma("unroll") for (int r = 0; r < 16; ++r) dst[crow(r, hi) * 128] = __float2bfloat16(acc[r]); } while (0)
  R1_LOAD(0);
  for (int s = 0; s < 17; ++s) {
#pragma unroll
    for (int q = 0; q < 2; ++q) *(bf16x8*)(Kimg + koff[q]) = scale8(kreg[q], kw[q]);
#pragma unroll
    for (int q = 0; q < 4; ++q) *(bf16x8*)(Vimg + voff[q]) = vreg[q];
    __syncthreads();
    if (s + 1 < 17) R1_LOAD(s + 1);
    if (s >= 2) { const int n = dir == 0 ? s - 2 : 17 - s; R1_STORE(n); }
#pragma unroll
    for (int r = 0; r < 16; ++r) acc[r] *= decay128;
#define R1_STEP(KT, KS) do { const s16x4 al = tr_read<(KT) * 16384 + v_rd_off(0, KS, 0)>(ka), ah = tr_read<(KT) * 16384 + v_rd_off(0, KS, 1)>(ka); \
      const s16x4 bl = tr_read<(KT) * 16384 + v_rd_off(0, KS, 0)>(va), bh = tr_read<(KT) * 16384 + v_rd_off(0, KS, 1)>(va); \
      asm volatile("s_waitcnt lgkmcnt(0)" ::: "memory"); SBAR(); \
      acc = __builtin_amdgcn_mfma_f32_32x32x16_bf16(PKF(al, ah), PKF(bl, bh), acc, 0, 0, 0); } while (0)
    R1_STEP(0, 0); R1_STEP(0, 1); R1_STEP(0, 2); R1_STEP(0, 3); R1_STEP(1, 0); R1_STEP(1, 1); R1_STEP(1, 2); R1_STEP(1, 3);
    __syncthreads();
  }
  { const int n = dir == 0 ? 15 : 0; R1_STORE(n); }
#undef R1_STEP
#undef R1_LOAD
#undef R1_STORE
#undef R1_ROWBASE
}
template <int DV2> __device__ __forceinline__ void pv_two(f32x16* o, int vb, bf16x8 pa0, bf16x8 pa1, bf16x8 pa2, bf16x8 pa3) {
  pv_one<0>(o[0], vb, pa0, pa1, pa2, pa3); pv_one<1>(o[1], vb, pa0, pa1, pa2, pa3);
}
__device__ __forceinline__ void ret_chunk(int b, int h, int n, const bf16* __restrict__ P, const bf16* __restrict__ St, const float* __restrict__ g_ret,
                                          float l2f, float l2b, bf16* __restrict__ Y, char* lds) {
  int tid_ = threadIdx.x; asm volatile("" : "+v"(tid_));
  const int tid = tid_, wid = tid >> 6, lane = tid & 63, r32 = lane & 31, hi = lane >> 5, wq = wid & 3, dvh = wid >> 2;
  char* Kt = lds; char* Vimg = lds + 16384; char* Simg = lds + 49152; float* Ot = (float*)lds;
  const long rowbase = (long)b * TOK + 256 + n * 128;
  bf16x8 qr[4];
  { const bf16* qp = P + (rowbase + 32 * wq + r32) * LDP + C_RQ + h * 64 + hi * 8;
#pragma unroll
    for (int d0 = 0; d0 < 4; ++d0) qr[d0] = ld8(qp + d0 * 16); }
#define KS128(row, colB) ((row) * 128 + ((colB) ^ (((row) & 7) << 4)))
  { bf16x8 kreg[2], vreg[4], sreg[4];
#pragma unroll
    for (int q = 0; q < 2; ++q) { const int c = tid + 512 * q; kreg[q] = ld8(P + (rowbase + (c >> 3)) * LDP + C_RK + h * 64 + (c & 7) * 8); }
#pragma unroll
    for (int q = 0; q < 4; ++q) { const int c = tid + 512 * q; vreg[q] = ld8(P + (rowbase + (c >> 4)) * LDP + C_RV + h * 128 + (c & 15) * 8);
      sreg[q] = ld8(St + ((long)((b * 4 + h) * 16 + n) * 128 + (c >> 4)) * 128 + (c & 15) * 8); }
#pragma unroll
    for (int q = 0; q < 2; ++q) { const int c = tid + 512 * q, row = c >> 3, col = (c & 7) * 8; *(bf16x8*)(Kt + KS128(row, col * 2)) = kreg[q]; }
#pragma unroll
    for (int q = 0; q < 4; ++q) { const int c = tid + 512 * q, row = c >> 4, col = (c & 15) * 8, off = (row >> 6) * 16384 + v_st(row & 63, col);
      *(bf16x8*)(Vimg + off) = vreg[q]; *(bf16x8*)(Simg + off) = sreg[q]; } }
  __syncthreads();
  f32x16 o[2] = {};
  const int i = 32 * wq + r32;
  const int vb = (int)(uintptr_t)Vimg + v_rd_base(lane) + dvh * 1024, sb = (int)(uintptr_t)Simg + v_rd_base(lane) + dvh * 1024;
#pragma nounroll
  for (int kt = 0; kt < 2; ++kt) {
    f32x16 p0 = {}, p1 = {};
#pragma unroll
    for (int d0 = 0; d0 < 4; ++d0) { const int cb = (d0 * 16 + hi * 8) * 2;
      const bf16x8 b0 = *reinterpret_cast<const bf16x8*>(Kt + KS128(64 * kt + r32, cb)), b1 = *reinterpret_cast<const bf16x8*>(Kt + KS128(64 * kt + 32 + r32, cb));
      p0 = __builtin_amdgcn_mfma_f32_32x32x16_bf16(b0, qr[d0], p0, 0, 0, 0); p1 = __builtin_amdgcn_mfma_f32_32x32x16_bf16(b1, qr[d0], p1, 0, 0, 0); }
#pragma unroll
    for (int r = 0; r < 16; ++r) { const int d0_ = i - (64 * kt + crow(r, hi)), d1_ = d0_ - 32;
      const float a0 = d0_ > 0 ? l2f * (float)d0_ : l2b * (float)(-d0_), a1 = d1_ > 0 ? l2f * (float)d1_ : l2b * (float)(-d1_);
      const float m0 = __builtin_amdgcn_exp2f(a0) * (d0_ == 0 ? 2.f : 1.f), m1 = __builtin_amdgcn_exp2f(a1) * (d1_ == 0 ? 2.f : 1.f);
      p0[r] *= m0; p1[r] *= m1; }
    bf16x8 pa0, pa1, pa2, pa3; PK4(p0, 0, pa0); PK4(p0, 8, pa1); PK4(p1, 0, pa2); PK4(p1, 8, pa3);
    pv_two<0>(o, vb + kt * 16384, pa0, pa1, pa2, pa3);
  }
  { const float sf = __builtin_amdgcn_exp2f(l2f * (float)(i + 1)), sbw = __builtin_amdgcn_exp2f(l2b * (float)(128 - i));
    pv_two<0>(o, sb, scale8(qr[0], sf), scale8(qr[1], sf), scale8(qr[2], sf), scale8(qr[3], sf));
    pv_two<0>(o, sb + 16384, scale8(qr[0], sbw), scale8(qr[1], sbw), scale8(qr[2], sbw), scale8(qr[3], sbw)); }
  __syncthreads();
#pragma unroll
  for (int d = 0; d < 2; ++d)
#pragma unroll
    for (int r = 0; r < 16; ++r) Ot[(32 * wq + crow(r, hi)) * 132 + 64 * dvh + 32 * d + r32] = o[d][r];
  __syncthreads();
  { const int row = tid >> 2, qd = tid & 3; const float* op = Ot + row * 132 + qd * 32;
    f32x4 v[8]; float s = 0.f;
#pragma unroll
    for (int j = 0; j < 8; ++j) { v[j] = *(const f32x4*)(op + 4 * j); s += (v[j][0] + v[j][1]) + (v[j][2] + v[j][3]); }
    s += __shfl_xor(s, 1); s += __shfl_xor(s, 2); const float mu = s * (1.f / 128.f); float q2 = 0.f;
#pragma unroll
    for (int j = 0; j < 8; ++j) { v[j] = v[j] - mu; q2 += (v[j][0] * v[j][0] + v[j][1] * v[j][1]) + (v[j][2] * v[j][2] + v[j][3] * v[j][3]); }
    q2 += __shfl_xor(q2, 1); q2 += __shfl_xor(q2, 2); const float rstd = rsqrtf(q2 * (1.f / 128.f) + EPS);
    const bf16* gp = P + (rowbase + row) * LDP + C_RG + h * 128 + qd * 32; const float* grp = g_ret + h * 128 + qd * 32;
    bf16* yp = Y + ((long)b * SEQ + n * 128 + row) * DM + h * 128 + qd * 32;
#pragma unroll
    for (int j = 0; j < 4; ++j) { const bf16x8 g8 = ld8(gp + 8 * j); const f32x4 ga = *(const f32x4*)(grp + 8 * j), gb = *(const f32x4*)(grp + 8 * j + 4); float y[8];
#pragma unroll
      for (int e = 0; e < 8; ++e) { const float gt = bf2f(g8[e]), sg = gt / (1.f + __expf(-gt)); const float ov = e < 4 ? v[2 * j][e] * ga[e] : v[2 * j + 1][e - 4] * gb[e - 4]; y[e] = ov * rstd * sg; }
      u32x4 w = {cvtpk(y[0], y[1]), cvtpk(y[2], y[3]), cvtpk(y[4], y[5]), cvtpk(y[6], y[7])}; *(u32x4*)(yp + 8 * j) = w; } }
  __syncthreads();
#undef KS128
}
#undef KSWZ
#undef SBAR
#undef PK4
#undef PKF
}
#define LAS __attribute__((address_space(3)))
typedef unsigned short bf16r;
typedef unsigned v4u __attribute__((ext_vector_type(4)));
typedef float f32x4 __attribute__((ext_vector_type(4)));
__device__ __forceinline__ unsigned f2bf(float f) { unsigned u = __builtin_bit_cast(unsigned, f); return (u + 0x7fffu + ((u >> 16) & 1u)) >> 16; }
__device__ __forceinline__ unsigned pk2(float lo, float hi) { return f2bf(lo) | (f2bf(hi) << 16); }
__device__ __forceinline__ float wave_sum(float v) {
#pragma unroll
    for (int o = 1; o < 64; o <<= 1) v += __shfl_xor(v, o);
    return v;
}
__device__ __forceinline__ int ileave64(int n) { const int d = n & 63; return (n & ~63) + (d < 32 ? 2 * d : 2 * (d - 32) + 1); }
template <int MAP> __device__ __forceinline__ int colmap(int n) {
    if (MAP == 1) return (n < 512 || n >= C_KPE) ? ileave64(n) : n;
    if (MAP == 2) { const int w = n % 192; return w >= 128 ? (n - w) + 128 + ileave64(w - 128) : n; }
    return n;
}
template <int MAP> __device__ __forceinline__ void transpose_item(const float* __restrict__ W, int K, int N, bf16r* __restrict__ WT, const float* __restrict__ kscale, float* scr, int item, int lane) {
    const int nblk = N / 32, kb = item / nblk, nb = item % nblk, k0 = 64 * kb, n0 = 32 * nb;
#pragma unroll 8
    for (int i = 0; i < 32; ++i) { const int kk = 2 * i + (lane >> 5); float v = W[(size_t)(k0 + kk) * N + n0 + (lane & 31)]; if (kscale) v *= kscale[k0 + kk]; scr[kk * 33 + (lane & 31)] = v; }
    asm volatile("s_waitcnt lgkmcnt(0)" ::: "memory");
    const int c = lane & 7;
#pragma unroll
    for (int j = 0; j < 4; ++j) { const int n = (lane >> 3) + 8 * j; const float* s = scr + (8 * c) * 33 + n;
        v4u o; o.x = pk2(s[0 * 33], s[1 * 33]); o.y = pk2(s[2 * 33], s[3 * 33]); o.z = pk2(s[4 * 33], s[5 * 33]); o.w = pk2(s[6 * 33], s[7 * 33]);
        *(v4u*)(WT + (size_t)colmap<MAP>(n0 + n) * K + k0 + 8 * c) = o; }
    asm volatile("s_waitcnt lgkmcnt(0)" ::: "memory");
}
__device__ __forceinline__ void norm_mod_row(const float* __restrict__ xrow, const float* __restrict__ g, const float* __restrict__ sh, const float* __restrict__ sc, bf16r* __restrict__ orow, int lane) {
    const f32x4* xr = (const f32x4*)xrow + lane; f32x4 v[4]; float s = 0.f;
#pragma unroll
    for (int j = 0; j < 4; ++j) { v[j] = xr[64 * j]; s += (v[j][0] * v[j][0] + v[j][1] * v[j][1]) + (v[j][2] * v[j][2] + v[j][3] * v[j][3]); }
    const float rstd = rsqrtf(wave_sum(s) * (1.f / DM) + EPS);
    unsigned long long* o8 = (unsigned long long*)orow + lane;
#pragma unroll
    for (int j = 0; j < 4; ++j) { const f32x4 gg = ((const f32x4*)g)[lane + 64 * j], hh = ((const f32x4*)sh)[lane + 64 * j], cc = ((const f32x4*)sc)[lane + 64 * j];
        const f32x4 y = (v[j] * rstd * gg) * (cc + 1.f) + hh;
        o8[64 * j] = (unsigned long long)pk2(y[0], y[1]) | ((unsigned long long)pk2(y[2], y[3]) << 32); }
}

#define RLX_AGENT __ATOMIC_RELAXED, __HIP_MEMORY_SCOPE_AGENT
#define XB_TMO      128
#define XB_XCNT(j)  (256  + 64 * (j))
#define XB_XSUB(j)  (1280 + 64 * (j))
#define XB_XGEN(j)  (2304 + 64 * (j))
#define XB_TOP      3328
#define XB_TOPGEN   3392
#define XCD_BAR_WORDS 3456
#define XB_SPIN_CAP (1u << 18)

__device__ __forceinline__ unsigned xb_ld(unsigned* p)              { return __hip_atomic_load(p, __ATOMIC_RELAXED, __HIP_MEMORY_SCOPE_AGENT); }
__device__ __forceinline__ unsigned xb_add(unsigned* p, unsigned v) { return __hip_atomic_fetch_add(p, v, __ATOMIC_RELAXED, __HIP_MEMORY_SCOPE_AGENT); }
__device__ __forceinline__ unsigned xb_xcc_id() { return (unsigned)__builtin_amdgcn_s_getreg((3 << 11) | 20) & 0xFu; }
#define XB_SPIN(cond, bar) do { unsigned _sp = 0; while (cond) { __builtin_amdgcn_s_sleep(1); \
    if ((++_sp & 255u) == 0u) { if (xb_ld(&(bar)[XB_TMO])) break; if (_sp > XB_SPIN_CAP) { atomicAdd(&(bar)[XB_TMO], 1u); break; } } } } while (0)

struct XcdBarrier {
    unsigned* bar; unsigned x;
    volatile LAS unsigned* st;
};

__device__ __forceinline__ XcdBarrier xcd_barrier_post(unsigned* bar, volatile LAS unsigned* st) {
    XcdBarrier b; b.bar = bar; b.x = xb_xcc_id(); b.st = st;
    if (threadIdx.x == 0) (void)xb_add(&bar[XB_XCNT(b.x)], 1u);
    return b;
}
__device__ __forceinline__ void xcd_barrier_complete(unsigned* bar, unsigned x, unsigned& nloc, unsigned& nx) {
    const unsigned G = gridDim.x * gridDim.y * gridDim.z;
    unsigned sum, cnt, mine, sp = 0u;
    for (;;) {
        sum = 0u; cnt = 0u; mine = 0u;
#pragma unroll
        for (unsigned j = 0; j < 16; ++j) { const unsigned c = xb_ld(&bar[XB_XCNT(j)]); sum += c; cnt += (c > 0u) ? 1u : 0u; mine = (j == x) ? c : mine; }
        if (sum == G) break;
        __builtin_amdgcn_s_sleep(1);
        if ((++sp & 255u) == 0u) { if (xb_ld(&bar[XB_TMO])) break; if (sp > XB_SPIN_CAP) { atomicAdd(&bar[XB_TMO], 1u); break; } }
    }
    nloc = mine > 0u ? mine : 1u; nx = cnt > 0u ? cnt : 1u;
}

__device__ __forceinline__ void xcd_barrier(const XcdBarrier& b) {
    asm volatile("s_waitcnt vmcnt(0)" ::: "memory");
    __syncthreads();
    if (threadIdx.x == 0) {
        unsigned* bar = b.bar;
        __builtin_amdgcn_s_waitcnt(0);
        unsigned nloc = b.st[0], nx = b.st[1];
        if (nloc == 0u) { xcd_barrier_complete(bar, b.x, nloc, nx); b.st[0] = nloc; b.st[1] = nx; }
        const unsigned old = xb_add(&bar[XB_XSUB(b.x)], 1u);
        const unsigned gen = old / nloc;
        if (old + 1u == (gen + 1u) * nloc) {
            __builtin_amdgcn_fence(__ATOMIC_RELEASE, "agent");
            asm volatile("s_waitcnt vmcnt(0)" ::: "memory");
            const unsigned og = xb_add(&bar[XB_TOP], 1u);
            const unsigned tg = og / nx;
            if (og + 1u == (tg + 1u) * nx) xb_add(&bar[XB_TOPGEN], 1u);
            else XB_SPIN(xb_ld(&bar[XB_TOPGEN]) == tg, bar);
            __builtin_amdgcn_fence(__ATOMIC_ACQUIRE, "agent");
            xb_add(&bar[XB_XGEN(b.x)], 1u);
            asm volatile("s_waitcnt vmcnt(0)" ::: "memory");
        } else {
            XB_SPIN(xb_ld(&bar[XB_XGEN(b.x)]) == gen, bar);
            __builtin_amdgcn_fence(__ATOMIC_ACQUIRE, "agent");
            asm volatile("s_waitcnt vmcnt(0)" ::: "memory");
        }
    }
    __syncthreads();
}

#define LAUNDER_V(x) asm volatile("" : "+v"(x))
#define LAUNDER_S(x) asm volatile("" : "+s"(x))
#ifdef PROBE_SYNC2
#define GSYNC() do { xcd_barrier(xbar); xcd_barrier(xbar); } while (0)
#else
#define GSYNC() xcd_barrier(xbar)
#endif
#ifndef PROBE_ATT_REP
#define PROBE_ATT_REP 1
#endif
#ifndef PROBE_RET_REP
#define PROBE_RET_REP 1
#endif
struct Args { const float* in[20]; float* out; unsigned char* ws; };
__global__ void __launch_bounds__(512, 2) fwd_megakernel(Args a) {
    extern __shared__ __attribute__((aligned(16))) unsigned char lds[];
    cg::grid_group grid = cg::this_grid();
    const int tid = threadIdx.x, lane = tid & 63, wave = __builtin_amdgcn_readfirstlane(tid >> 6), G = gridDim.x, bx = blockIdx.x;
    const int gw = bx * 8 + wave, NGW = G * 8;
    unsigned char* ws = a.ws;
    const float *x = a.in[0], *cvec = a.in[1], *ctx = a.in[2], *c_ctx = a.in[3], *w_ada = a.in[4], *b_ada = a.in[5], *g_attn = a.in[6], *g_ffn = a.in[7], *w_in = a.in[8],
                *dec_f = a.in[9], *dec_b = a.in[10], *g_ret = a.in[11], *g_q = a.in[12], *w_uq = a.in[13], *g_kv = a.in[14], *w_ukv = a.in[15], *w_out = a.in[16], *w_ff1 = a.in[17], *w_ff2 = a.in[18], *g_final = a.in[19];
    float* mod = (float*)(ws + WS_MOD); float* rope = (float*)(ws + WS_ROPE); float* ssq = (float*)(ws + WS_SSQ);
    bf16r *WinT = (bf16r*)(ws + WS_WIN), *WuqT = (bf16r*)(ws + WS_WUQ), *WukvT = (bf16r*)(ws + WS_WUKV), *WoutT = (bf16r*)(ws + WS_WOUT), *W1T = (bf16r*)(ws + WS_W1), *W2T = (bf16r*)(ws + WS_W2);
    bf16r *HN = (bf16r*)(ws + WS_HN), *P = (bf16r*)(ws + WS_P), *Q = (bf16r*)(ws + WS_Q), *KV = (bf16r*)(ws + WS_KV), *ST = (bf16r*)(ws + WS_ST), *HID = (bf16r*)(ws + WS_HID);
    bf16r *Y = HN, *H2 = HN;
    PG8_LAS unsigned char* ldsl = (PG8_LAS unsigned char*)lds;
    volatile LAS unsigned* xst = (volatile LAS unsigned*)((LAS unsigned char*)lds + LDS_BYTES - 64);
    if (tid < 16) xst[tid] = 0u;
    __syncthreads();
    const XcdBarrier xbar = xcd_barrier_post((unsigned*)(ws + WS_CTL), xst);

#if !defined(NO_P0)
    if (bx < 96) {
        int tid = threadIdx.x, lane = tid & 63; LAUNDER_V(tid); LAUNDER_V(lane);
        float* sl = (float*)lds; float* red = (float*)(lds + 17 * 1024 * 4);
        for (int idx = tid; idx < 17 * 1024; idx += 512) { const int r = idx >> 10, k = idx & 1023; const float cv = r < 16 ? cvec[r * 1024 + k] : c_ctx[k]; sl[idx] = cv / (1.f + __expf(-cv)); }
        __syncthreads();
        const int n0 = bx * 64; float acc[17];
#pragma unroll
        for (int r = 0; r < 17; ++r) acc[r] = 0.f;
        for (int kk = 0; kk < 128; kk += 4) { const int k = wave * 128 + kk; const float* wp = w_ada + (size_t)k * 6144 + n0 + lane;
            const float w0 = wp[0], w1 = wp[6144], w2 = wp[2 * 6144], w3 = wp[3 * 6144];
#pragma unroll
            for (int r = 0; r < 17; ++r) { const f32x4 sv = *(const f32x4*)(sl + r * 1024 + k); acc[r] += (sv[0] * w0 + sv[1] * w1) + (sv[2] * w2 + sv[3] * w3); } }
#pragma unroll
        for (int r = 0; r < 17; ++r) red[(wave * 17 + r) * 64 + lane] = acc[r];
        __syncthreads();
        for (int idx = tid; idx < 17 * 64; idx += 512) { const int r = idx >> 6, l = idx & 63; float s = b_ada[n0 + l];
#pragma unroll
            for (int w = 0; w < 8; ++w) s += red[(w * 17 + r) * 64 + l];
            mod[r * 6144 + n0 + l] = s; }
        __syncthreads();
    }
    {
        int tid = threadIdx.x, lane = tid & 63; LAUNDER_V(tid); LAUNDER_V(lane);
        float* scr = (float*)(lds + wave * 16384);
        constexpr int I_IN = (DM / 64) * (NIN / 32), I_UQ = (QL / 64) * (NQ / 32), I_UKV = (KVL / 64) * (NKV / 32), I_OUT = (DM / 64) * (DM / 32), I_1 = (DM / 64) * (DFF / 32), I_2 = (DFF / 64) * (DM / 32);
        constexpr int NITEMS = I_IN + I_UQ + I_UKV + I_OUT + I_1 + I_2;
        for (int it = gw; it < NITEMS; it += NGW) {
            int r = it;
            if (r < I_IN) { transpose_item<1>(w_in, DM, NIN, WinT, nullptr, scr, r, lane); continue; } r -= I_IN;
            if (r < I_UQ) { transpose_item<2>(w_uq, QL, NQ, WuqT, g_q, scr, r, lane); continue; } r -= I_UQ;
            if (r < I_UKV) { transpose_item<0>(w_ukv, KVL, NKV, WukvT, g_kv, scr, r, lane); continue; } r -= I_UKV;
            if (r < I_OUT) { transpose_item<0>(w_out, DM, DM, WoutT, nullptr, scr, r, lane); continue; } r -= I_OUT;
            if (r < I_1) { transpose_item<0>(w_ff1, DM, DFF, W1T, nullptr, scr, r, lane); continue; } r -= I_1;
            transpose_item<0>(w_ff2, DFF, DM, W2T, nullptr, scr, r, lane);
        }
        for (int i = bx * 512 + tid; i < 64 * DM / 8; i += G * 512) ((v4u*)(WinT + (size_t)NIN * DM))[i] = (v4u){0u, 0u, 0u, 0u};
        for (int i = bx * 512 + tid; i < SEQ * 32; i += G * 512) { const int t = i >> 5, j = i & 31; const float pos = (float)(j < 16 ? (t >> 6) : (t & 63));
            const float freq = powf(10000.f, -(float)(j & 15) / 16.f); const float ang = pos * freq; rope[2 * i] = cosf(ang); rope[2 * i + 1] = sinf(ang); }
    }
#endif
    grid.sync();
    { int gw1 = gw, ln = lane; LAUNDER_S(gw1); LAUNDER_V(ln);
    for (int row = gw1; row < MALL; row += NGW) { const int b = row / TOK, j = row % TOK;
        const float* src = j < CTXL ? ctx + ((size_t)b * CTXL + j) * DM : x + ((size_t)b * SEQ + (j - CTXL)) * DM; const float* md = mod + (size_t)(j < CTXL ? 16 : b) * 6144;
        norm_mod_row(src, g_attn, md, md + 1024, HN + (size_t)row * DM, ln); } }
    GSYNC();
#if !defined(NO_GEMM)
    { pg8::Gemm g{HN, WinT, MALL, NINP, DM, DM}; pg8::StaticOrder S; S.init(MALL, NINP, G, bx);
      pg8::EpiInProj E{P, ssq, rope};
      pg8::gemm_phase<pg8::EpiInProj, pg8::StaticOrder, true, true>(ldsl, g, S, E); }
#endif
    GSYNC();
#if !defined(NO_R1)
    for (int rep = 0; rep < PROBE_RET_REP; ++rep)
    if (bx < 128) att::ret_states(bx, (const att::bf16*)P, (att::bf16*)ST, dec_f, dec_b, (char*)lds);
#endif
#if !defined(NO_GUQ)
    { pg8::Gemm g{P + C_CQ, WuqT, MALL, NQ, QL, NINP}; pg8::StaticOrder S; S.init(MALL, NQ, G, bx);
      pg8::EpiUpQ E{Q};
      pg8::gemm_phase<pg8::EpiUpQ, pg8::StaticOrder, true, true>(ldsl, g, S, E); }
#endif
#if !defined(NO_GUKV)
    { pg8::Gemm g{P + C_CKV, WukvT, MALL, NKV, KVL, NINP}; pg8::StaticOrder S; S.init(MALL, NKV, G, bx);
      pg8::EpiUpKV E{KV, ssq};
      pg8::gemm_phase<pg8::EpiUpKV, pg8::StaticOrder, true, true>(ldsl, g, S, E); }
#endif
    GSYNC();
#if !defined(NO_ATT)
    for (int rep = 0; rep < PROBE_ATT_REP; ++rep)
    for (int u = bx; u < 512; u += G) { const int xcd = u & 7, idx = u >> 3, bh = xcd * 8 + (idx >> 3), qb = idx & 7, b = bh >> 2, h = bh & 3;
        const size_t krow = (size_t)b * TOK;
        att::attn_body((const att::bf16*)Q + (krow + CTXL + qb * 256) * NQ + h * 192, (const att::bf16*)KV + krow * NKV + h * 256, (const att::bf16*)KV + krow * NKV + h * 256 + 128,
                       (const att::bf16*)P + krow * NINP + C_KPE, (att::bf16*)Y + ((size_t)b * SEQ + qb * 256) * DM + 512 + h * 128, rope + (size_t)qb * 256 * 64, ssq + (krow + CTXL + qb * 256) * 24, TOK, (char*)lds); }
#endif
#if !defined(NO_R2)
    for (int rep = 0; rep < PROBE_RET_REP; ++rep)
    for (int u = bx; u < 1024; u += G) { const int xcd = u & 7, idx = u >> 3, bh = xcd * 8 + (idx >> 4), n = idx & 15, b = bh >> 2, h = bh & 3;
        const float l2f = -log1pf(expf(-dec_f[h])) * 1.4426950408889634f, l2b = -log1pf(expf(-dec_b[h])) * 1.4426950408889634f;
        att::ret_chunk(b, h, n, (const att::bf16*)P, (const att::bf16*)ST, g_ret, l2f, l2b, (att::bf16*)Y, (char*)lds); }
#endif
    GSYNC();
#if !defined(NO_GOUT)
    { pg8::Gemm g{Y, WoutT, MLAT, DM, DM, DM}; pg8::StaticOrder S; S.init(MLAT, DM, G, bx);
      pg8::EpiGateRes E{x, a.out, mod + 2048};
      pg8::gemm_phase<pg8::EpiGateRes, pg8::StaticOrder, true, true>(ldsl, g, S, E); }
#endif
    GSYNC();
    { int gw1 = gw, ln = lane; LAUNDER_S(gw1); LAUNDER_V(ln);
    for (int row = gw1; row < MLAT; row += NGW) { const float* md = mod + (size_t)(row / SEQ) * 6144;
        norm_mod_row(a.out + (size_t)row * DM, g_ffn, md + 3072, md + 4096, H2 + (size_t)row * DM, ln); } }
    GSYNC();
#if !defined(NO_GFF1)
    { pg8::Gemm g{H2, W1T, MLAT, DFF, DM, DM}; pg8::StaticOrder S; S.init(MLAT, DFF, G, bx);
      pg8::EpiRelu2 E{HID};
      pg8::gemm_phase<pg8::EpiRelu2, pg8::StaticOrder, true, true>(ldsl, g, S, E); }
#endif
    GSYNC();
#if !defined(NO_GFF2)
    { pg8::Gemm g{HID, W2T, MLAT, DM, DFF, DFF}; pg8::StaticOrder S; S.init(MLAT, DM, G, bx);
      pg8::EpiGateRes E{a.out, a.out, mod + 5120};
      pg8::gemm_phase<pg8::EpiGateRes, pg8::StaticOrder, true, true>(ldsl, g, S, E); }
#endif
    GSYNC();
    { int gw1 = gw, ln = lane; LAUNDER_S(gw1); LAUNDER_V(ln);
    for (int row = gw1; row < MLAT; row += NGW) { f32x4* xr = (f32x4*)(a.out + (size_t)row * DM) + ln; f32x4 v[4]; float s = 0.f;
#pragma unroll
        for (int j = 0; j < 4; ++j) { v[j] = xr[64 * j]; s += (v[j][0] * v[j][0] + v[j][1] * v[j][1]) + (v[j][2] * v[j][2] + v[j][3] * v[j][3]); }
        const float rstd = rsqrtf(wave_sum(s) * (1.f / DM) + EPS);
#pragma unroll
        for (int j = 0; j < 4; ++j) xr[64 * j] = v[j] * rstd * ((const f32x4*)g_final)[ln + 64 * j]; } }
}

extern "C" void kernel_launch(void* const* d_in, const int* in_sizes, int n_in, void* d_out, int out_size, void* d_ws, size_t ws_size, hipStream_t stream) {
    static int grid = 0;
    if (grid == 0) {
        if (n_in != 20 || in_sizes[0] != MLAT * DM || out_size != MLAT * DM || ws_size < WS_END) { fprintf(stderr, "kernel_launch: unexpected shapes / workspace (n_in %d, ws %zu)\n", n_in, ws_size); grid = -1; return; }
        int dev = 0, cus = 0, per_cu = 0;
        (void)hipGetDevice(&dev); (void)hipDeviceGetAttribute(&cus, hipDeviceAttributeMultiprocessorCount, dev);
        if (hipFuncSetAttribute((const void*)fwd_megakernel, hipFuncAttributeMaxDynamicSharedMemorySize, LDS_BYTES) != hipSuccess) { fprintf(stderr, "kernel_launch: hipFuncSetAttribute failed\n"); grid = -1; return; }
        if (hipOccupancyMaxActiveBlocksPerMultiprocessor(&per_cu, (const void*)fwd_megakernel, 512, LDS_BYTES) != hipSuccess || per_cu < 1) { fprintf(stderr, "kernel_launch: occupancy query says %d\n", per_cu); grid = -1; return; }
        grid = cus;
    }
    if (grid < 0) return;
    if (hipMemsetAsync((char*)d_ws + WS_CTL, 0, CTL_BYTES, stream) != hipSuccess) { fprintf(stderr, "kernel_launch: memset failed\n"); return; }
    Args a{};
    for (int i = 0; i < 20; ++i) a.in[i] = (const float*)d_in[i];
    a.out = (float*)d_out; a.ws = (unsigned char*)d_ws;
    void* args[] = {&a};
    hipError_t e = hipLaunchCooperativeKernel((const void*)fwd_megakernel, dim3(grid), dim3(512), args, LDS_BYTES, stream);
    if (e != hipSuccess) fprintf(stderr, "cooperative launch failed: %s (grid %d)\n", hipGetErrorString(e), grid);
}
```

```cpp
#include <hip/hip_runtime.h>
#include <hip/hip_bf16.h>
#include <hip/hip_cooperative_groups.h>
#include <cstdio>
#include <cstdint>
namespace cg = cooperative_groups;

constexpr int DM = 1024, NB = 16, SEQ = 2048, CTXL = 256, TOK = SEQ + CTXL, MALL = NB * TOK, MLAT = NB * SEQ;
constexpr int NIN = 2240, NINP = 2304, DFF = 4096, QL = 384, KVL = 256, NQ = 768, NKV = 1024;
constexpr float EPS = 1e-6f;
constexpr int C_RQ = 0, C_RK = 256, C_RV = 512, C_RG = 1024, C_CQ = 1536, C_CKV = 1920, C_KPE = 2176;
constexpr size_t MiB = 1u << 20;
constexpr size_t WS_MOD = 0, WS_ROPE = MiB / 2, WS_WIN = 1 * MiB, WS_WUQ = 6 * MiB, WS_WUKV = 7 * MiB, WS_WOUT = 8 * MiB, WS_W1 = 10 * MiB, WS_W2 = 18 * MiB;
constexpr size_t WS_SSQ = 26 * MiB, WS_ST = 34 * MiB, WS_HN = 66 * MiB, WS_P = 138 * MiB, WS_Q = 300 * MiB, WS_KV = 354 * MiB, WS_CTL = 426 * MiB, CTL_BYTES = 16384, WS_XMB = 427 * MiB, WS_END = 491 * MiB;
constexpr size_t WS_HID = WS_P;
static_assert(WS_P + (size_t)MALL * NINP * 2 <= WS_Q && WS_Q + (size_t)MALL * NQ * 2 <= WS_KV && WS_KV + (size_t)MALL * NKV * 2 <= WS_CTL && WS_HID + (size_t)MLAT * DFF * 2 <= WS_CTL, "ws map");
static_assert(WS_HN + (size_t)MALL * DM * 2 <= WS_P && WS_ST + (size_t)NB * 4 * 16 * 128 * 128 * 2 <= WS_HN && WS_SSQ + (size_t)MALL * 24 * 4 <= WS_ST, "ws map 2");
constexpr int LDS_BYTES = 147456;

#ifndef ATT_SDEPTH
#define ATT_SDEPTH 1
#endif
#ifndef ATT_NQREG
#define ATT_NQREG 11
#endif
namespace pg8 {
#define PG8_LAS __attribute__((address_space(3)))
typedef unsigned short bf16_t;
typedef short bf16x8 __attribute__((ext_vector_type(8)));
typedef float f32x4 __attribute__((ext_vector_type(4)));
typedef unsigned u32x4 __attribute__((ext_vector_type(4)));
constexpr int BM = 256, BK = 64, HALF = 128, HTB = HALF * BK * 2  , STAGE_BYTES = 8 * HTB, NXCD = 8, WGM = 8;

__host__ __device__ __forceinline__ int lds_byte(int r, int c) { const int st = (r >> 4) * 2 + (c >> 5), rr = r & 15, cc = c & 31, ob = rr * 64 + cc * 2; return st * 1024 + (ob ^ (((ob >> 9) & 1) << 5)); }
__host__ __device__ __forceinline__ void stage_rc(int b, int& R, int& C) { const int st = b / 1024, sb = b % 1024, swz = sb ^ (((sb >> 9) & 1) << 5); R = (st >> 1) * 16 + swz / 64; C = (st & 1) * 32 + (swz % 64) / 2; }
__host__ __device__ __forceinline__ int perm32(int rho) { const int n = rho >> 4, i = rho & 15; return 8 * (i >> 2) + 4 * n + (i & 3); }

struct Unit { int pm, pn; };
struct Gemm { const bf16_t* A; const bf16_t* Bt; int M, N, K, lda; };

struct StaticOrder {
    int nM, nN, nwg, G, c;
    __host__ __device__ void init(int M, int N, int G_, int c_) { nM = M / BM; nN = N / BM; nwg = nM * nN; G = G_; c = c_; }
    __host__ __device__ bool next(int i, Unit& u) const {
        const long L = (long)i * G + c; if (L >= nwg) return false;
        int wgid = (int)L; { const int q = nwg / NXCD, r = nwg % NXCD, xcd = wgid % NXCD, off = wgid / NXCD; wgid = (xcd < r ? xcd * (q + 1) : r * (q + 1) + (xcd - r) * q) + off; }
        const int nig = WGM * nN, gid = wgid / nig, fm = gid * WGM, gsz = (nM - fm) < WGM ? (nM - fm) : WGM;
        u.pm = fm + ((wgid % nig) % gsz); u.pn = (wgid % nig) / gsz; return true;
    }
    __device__ __forceinline__ void a_ready(const Unit&) const {}
    __device__ __forceinline__ void done(const Unit&) const {}
};


struct InProjOrder {
    int G, c;
    __host__ __device__ void init(int G_, int c_) { G = G_; c = c_; }
    __host__ __device__ bool next(int i, Unit& u) const {
        const long L = (long)i * G + c; if (L >= 1280) return false;
        int wgid = (int)L; { const int q = 1280 / NXCD, xcd = wgid % NXCD, off = wgid / NXCD; wgid = xcd * q + off; }
        const int b = wgid / 80; int r = wgid % 80, pn, pw;
        if (r < 54) { pn = r / 9; pw = r % 9; } else if (r < 62) { pn = 6; pw = 1 + (r - 54); } else { r -= 62; pn = 7 + r / 9; pw = r % 9; }
        u.pm = b * 9 + pw; u.pn = pn; return true;
    }
    __device__ __forceinline__ void a_ready(const Unit&) const {}
    __device__ __forceinline__ void done(const Unit&) const {}
};
__device__ __forceinline__ unsigned cvt_pk_bf16(float lo, float hi) { unsigned r; asm volatile("v_cvt_pk_bf16_f32 %0, %1, %2" : "=v"(r) : "v"(lo), "v"(hi)); return r; }
typedef float f32x2 __attribute__((ext_vector_type(2)));
__device__ __forceinline__ void store8(bf16_t* p, const f32x4 v0, const f32x4 v1) {
    u32x4 w; w.x = cvt_pk_bf16(v0[0], v0[1]); w.y = cvt_pk_bf16(v0[2], v0[3]); w.z = cvt_pk_bf16(v1[0], v1[1]); w.w = cvt_pk_bf16(v1[2], v1[3]); *(u32x4*)p = w;
}
__device__ __forceinline__ void rope8(f32x4& v0, f32x4& v1, const float* cs) {
    const f32x4 a = *(const f32x4*)cs, b = *(const f32x4*)(cs + 4); f32x4 o0, o1;
    o0[0] = v0[0] * a[0] - v0[1] * a[1]; o0[1] = v0[1] * a[0] + v0[0] * a[1]; o0[2] = v0[2] * a[2] - v0[3] * a[3]; o0[3] = v0[3] * a[2] + v0[2] * a[3];
    o1[0] = v1[0] * b[0] - v1[1] * b[1]; o1[1] = v1[1] * b[0] + v1[0] * b[1]; o1[2] = v1[2] * b[2] - v1[3] * b[3]; o1[3] = v1[3] * b[2] + v1[2] * b[3];
    v0 = o0; v1 = o1;
}
__device__ __forceinline__ float dot4(const f32x4 a) { return (a[0] * a[0] + a[1] * a[1]) + (a[2] * a[2] + a[3] * a[3]); }
struct EpiInProj {
    static constexpr bool PERM = true, AFTER_DRAIN = false;
    bf16_t* P; float* ssq; const float* rope;
    __device__ __forceinline__ void operator()(const f32x4 (&acc)[2][2][4][2], const Unit& u, int wr, int wc, int fr, int fq) const {
        const int pmw = u.pm % 9; const bool latent = pmw != 0;
        const int trow0 = (pmw - 1) * 256 + wr * 64 + fr, row0 = u.pm * BM + wr * 64 + fr;
#pragma unroll
        for (int bj = 0; bj < 2; ++bj) {
            const int seg = u.pn * 2 + bj, col0 = u.pn * BM + bj * HALF + wc * 32 + 8 * fq;
            int kind;
            if (seg < 2) kind = 1; else if (seg < 4) kind = 2; else if (seg < 12) kind = 0; else if (seg < 17) kind = 3; else kind = (wc < 2) ? 1 : 4;
            if (kind != 4) {
                const float sc = (kind == 2) ? 0.125f : 1.f; const bool dorope = latent && (kind == 1 || kind == 2);
                const int i0 = (col0 & 63) >> 1, slot = (u.pn - 6) * 8 + bj * 4 + wc;
#pragma unroll
                for (int ai = 0; ai < 2; ++ai)
#pragma unroll
                    for (int m = 0; m < 4; ++m) {
                        f32x4 v0 = acc[ai][bj][m][0] * sc, v1 = acc[ai][bj][m][1] * sc; const int roff = ai * HALF + m * 16;
                        if (dorope) rope8(v0, v1, rope + ((size_t)(trow0 + roff) * 32 + i0) * 2);
                        if (kind == 3) { float s = dot4(v0) + dot4(v1); s += __shfl_xor(s, 16); s += __shfl_xor(s, 32); if (fq == 0) ssq[(size_t)(row0 + roff) * 24 + slot] = s; }
                        store8(P + (size_t)(row0 + roff) * NINP + col0, v0, v1);
                    }
            }
        }
    }
};
struct EpiUpQ {
    static constexpr bool PERM = true, AFTER_DRAIN = false;
    bf16_t* Q;
    __device__ __forceinline__ void operator()(const f32x4 (&acc)[2][2][4][2], const Unit& u, int wr, int wc, int fr, int fq) const {
        const int row0 = u.pm * BM + wr * 64 + fr;
#pragma unroll
        for (int bj = 0; bj < 2; ++bj) {
            const int col0 = u.pn * BM + bj * HALF + wc * 32 + 8 * fq;
#pragma unroll
            for (int ai = 0; ai < 2; ++ai)
#pragma unroll
                for (int m = 0; m < 4; ++m) store8(Q + (size_t)(row0 + ai * HALF + m * 16) * NQ + col0, acc[ai][bj][m][0], acc[ai][bj][m][1]);
        }
    }
};
struct EpiUpKV {
    static constexpr bool PERM = true, AFTER_DRAIN = false;
    bf16_t* KV; const float* ssq;
    __device__ __forceinline__ void operator()(const f32x4 (&acc)[2][2][4][2], const Unit& u, int wr, int wc, int fr, int fq) const {
        const int row0 = u.pm * BM + wr * 64 + fr;
#pragma unroll
        for (int ai = 0; ai < 2; ++ai)
#pragma unroll
            for (int m = 0; m < 4; ++m) { const int roff = ai * HALF + m * 16;
                const float* s = ssq + (size_t)(row0 + roff) * 24 + 12; const f32x4 a = *(const f32x4*)s, b = *(const f32x4*)(s + 4);
                const float t = ((a[0] + a[1]) + (a[2] + a[3])) + ((b[0] + b[1]) + (b[2] + b[3])); const float rs = rsqrtf(t * (1.f / KVL) + EPS);
#pragma unroll
                for (int bj = 0; bj < 2; ++bj) { const int col0 = u.pn * BM + bj * HALF + wc * 32 + 8 * fq;
                    store8(KV + (size_t)(row0 + roff) * NKV + col0, acc[ai][bj][m][0] * rs, acc[ai][bj][m][1] * rs); }
                asm volatile("" ::: "memory"); }
    }
};
template <bool BASE_BF16> struct EpiGateRes {
    static constexpr bool PERM = true, AFTER_DRAIN = false;
    const void* base; bf16_t* out; const float* gate;
    __device__ __forceinline__ void operator()(const f32x4 (&acc)[2][2][4][2], const Unit& u, int wr, int wc, int fr, int fq) const {
        const int row0 = u.pm * BM + wr * 64 + fr, b = u.pm >> 3;
#pragma unroll
        for (int bj = 0; bj < 2; ++bj) {
            const int col0 = u.pn * BM + bj * HALF + wc * 32 + 8 * fq;
            const f32x4 g0 = *(const f32x4*)(gate + (size_t)b * 6144 + col0), g1 = *(const f32x4*)(gate + (size_t)b * 6144 + col0 + 4);
#pragma unroll
            for (int ai = 0; ai < 2; ++ai)
#pragma unroll
                for (int m = 0; m < 4; ++m) { const size_t off = (size_t)(row0 + ai * HALF + m * 16) * DM + col0; f32x4 x0, x1;
                    if (BASE_BF16) { const u32x4 w = *(const u32x4*)((const bf16_t*)base + off);
                        x0 = (f32x4){__uint_as_float(w.x << 16), __uint_as_float(w.x & 0xffff0000u), __uint_as_float(w.y << 16), __uint_as_float(w.y & 0xffff0000u)};
                        x1 = (f32x4){__uint_as_float(w.z << 16), __uint_as_float(w.z & 0xffff0000u), __uint_as_float(w.w << 16), __uint_as_float(w.w & 0xffff0000u)}; }
                    else { x0 = *(const f32x4*)((const float*)base + off); x1 = *(const f32x4*)((const float*)base + off + 4); }
                    store8(out + off, x0 + g0 * acc[ai][bj][m][0], x1 + g1 * acc[ai][bj][m][1]); }
        }
    }
};
struct EpiRelu2 {
    static constexpr bool PERM = true, AFTER_DRAIN = false;
    bf16_t* H;
    __device__ __forceinline__ void operator()(const f32x4 (&acc)[2][2][4][2], const Unit& u, int wr, int wc, int fr, int fq) const {
        const int row0 = u.pm * BM + wr * 64 + fr;
#pragma unroll
        for (int bj = 0; bj < 2; ++bj) {
            const int col0 = u.pn * BM + bj * HALF + wc * 32 + 8 * fq;
#pragma unroll
            for (int ai = 0; ai < 2; ++ai)
#pragma unroll
                for (int m = 0; m < 4; ++m) { f32x4 v0 = acc[ai][bj][m][0], v1 = acc[ai][bj][m][1];
#pragma unroll
                    for (int e = 0; e < 4; ++e) { const float a = fmaxf(v0[e], 0.f), c = fmaxf(v1[e], 0.f); v0[e] = a * a; v1[e] = c * c; }
                    store8(H + (size_t)(row0 + ai * HALF + m * 16) * DFF + col0, v0, v1); }
        }
    }
};
template <class Epi, class Sched, bool ALIGN_EPI = false, bool SP2 = false>
__device__ __forceinline__ void gemm_phase(PG8_LAS unsigned char* lds, const Gemm g, const Sched& S, const Epi& E) {
    int tid_ = threadIdx.x; asm volatile("" : "+v"(tid_));
    const int tid = tid_, wid = __builtin_amdgcn_readfirstlane(tid >> 6), lane = tid & 63, wr = wid >> 2, wc = wid & 3, fr = lane & 15, fq = lane >> 4;
    const int K = g.K, nt = K / BK;
    unsigned voffA[2], voffB[2];
#pragma unroll
    for (int i = 0; i < 2; ++i) { int R, C; stage_rc(tid * 16 + i * 8192, R, C); const int Rb = Epi::PERM ? ((R & ~31) + perm32(R & 31)) : R;
        voffA[i] = (unsigned)(R * g.lda + C) * 2u; voffB[i] = (unsigned)(Rb * K + C) * 2u; }
    const size_t kstep = (size_t)(BK * 2);
    const size_t hstepA = (size_t)HALF * g.lda * 2, hstepB = (size_t)HALF * K * 2;
    const size_t tstepA = 2 * hstepA, tstepB = 2 * hstepB;
    const unsigned ldsw = (unsigned)wid * 1024u;
    const int aoff = lds_byte(wr * 64 + fr, fq * 8), boff = lds_byte(wc * 32 + fr, fq * 8);
#define PG8_SA(b, h) (((b) * 2 + (h)) * HTB)
#define PG8_SB(b, h) ((4 + (b) * 2 + (h)) * HTB)
#define PG8_STAGE(bufoff, gbase, voff) do { _Pragma("unroll") for (int _i = 0; _i < 2; ++_i) \
        __builtin_amdgcn_global_load_lds((const unsigned*)((const char*)(gbase) + (voff)[_i]), (PG8_LAS unsigned*)(lds + (bufoff) + ldsw + _i * 8192), 16, 0, 0); } while (0)
#define PG8_LDA(dst, b, h) do { _Pragma("unroll") for (int m = 0; m < 4; ++m) _Pragma("unroll") for (int k = 0; k < 2; ++k) dst[m][k] = *(const PG8_LAS bf16x8*)(lds + PG8_SA(b, h) + aoff + m * 2048 + k * 1024); } while (0)
#define PG8_LDB(dst, b, h) do { _Pragma("unroll") for (int n = 0; n < 2; ++n) _Pragma("unroll") for (int k = 0; k < 2; ++k) dst[n][k] = *(const PG8_LAS bf16x8*)(lds + PG8_SB(b, h) + boff + n * 2048 + k * 1024); } while (0)
#define PG8_MMA(ai, bj, At, Bt) do { __builtin_amdgcn_s_setprio(1); _Pragma("unroll") for (int m = 0; m < 4; ++m) _Pragma("unroll") for (int n = 0; n < 2; ++n) _Pragma("unroll") for (int k = 0; k < 2; ++k) \
        acc[ai][bj][m][n] = __builtin_amdgcn_mfma_f32_16x16x32_bf16(Bt[n][k], At[m][k], acc[ai][bj][m][n], 0, 0, 0); __builtin_amdgcn_s_setprio(0); } while (0)
#define PG8_WAIT_V(n) asm volatile("s_waitcnt vmcnt(" #n ")" ::: "memory")
#define PG8_WAIT_L(n) asm volatile("s_waitcnt lgkmcnt(" #n ")" ::: "memory")
#define PG8_BAR __builtin_amdgcn_s_barrier()
#define PG8_SCHED __builtin_amdgcn_sched_barrier(0)
    Unit cur, nxt; int ui = 0;
    if (!S.next(0, cur)) return;
    f32x4 acc[2][2][4][2];
#pragma unroll
    for (int a = 0; a < 2; ++a)
#pragma unroll
        for (int b = 0; b < 2; ++b)
#pragma unroll
            for (int m = 0; m < 4; ++m)
#pragma unroll
                for (int n = 0; n < 2; ++n) acc[a][b][m][n] = (f32x4){0.f, 0.f, 0.f, 0.f};
    bf16x8 At[4][2], B0[2][2], B1[2][2];
    const char* cA = (const char*)g.A + (size_t)cur.pm * tstepA; const char* cB = (const char*)g.Bt + (size_t)cur.pn * tstepB;
    S.a_ready(cur);
    if constexpr (SP2) {
        PG8_STAGE(PG8_SB(0, 0), cB, voffB); PG8_STAGE(PG8_SB(0, 1), cB + hstepB, voffB); PG8_STAGE(PG8_SA(0, 0), cA, voffA); PG8_STAGE(PG8_SA(0, 1), cA + hstepA, voffA);
        if (wr == 1) PG8_BAR;
        PG8_WAIT_V(2); PG8_BAR;
        PG8_STAGE(PG8_SB(1, 0), cB + kstep, voffB); PG8_STAGE(PG8_SA(1, 0), cA + kstep, voffA); PG8_STAGE(PG8_SB(1, 1), cB + hstepB + kstep, voffB);
        PG8_WAIT_V(6); PG8_BAR;
    } else {
        PG8_STAGE(PG8_SB(0, 0), cB, voffB); PG8_STAGE(PG8_SA(0, 0), cA, voffA); PG8_STAGE(PG8_SB(0, 1), cB + hstepB, voffB); PG8_STAGE(PG8_SA(0, 1), cA + hstepA, voffA);
        if (wr == 1) PG8_BAR;
        PG8_WAIT_V(4); PG8_BAR;
        PG8_STAGE(PG8_SB(1, 0), cB + kstep, voffB); PG8_STAGE(PG8_SA(1, 0), cA + kstep, voffA); PG8_STAGE(PG8_SB(1, 1), cB + hstepB + kstep, voffB);
        PG8_WAIT_V(6); PG8_BAR;
    }
    for (;;) {
        const bool has_next = S.next(ui + 1, nxt);
        const char* nA = has_next ? (const char*)g.A + (size_t)nxt.pm * tstepA : cA; const char* nB = has_next ? (const char*)g.Bt + (size_t)nxt.pn * tstepB : cB;
#pragma nounroll
        for (int t = 0; t < nt; t += 2) {
            const bool last = (t == nt - 2);
            const char* a1 = cA + (size_t)(t + 1) * kstep;
            const char* a2 = last ? nA : cA + (size_t)(t + 2) * kstep; const char* b2 = last ? nB : cB + (size_t)(t + 2) * kstep;
            const char* a3 = a2 + kstep; const char* b3 = b2 + kstep;
            if (last && has_next) S.a_ready(nxt);
            if constexpr (SP2) {
            PG8_LDB(B0, 0, 0); PG8_LDB(B1, 0, 1); PG8_SCHED; PG8_LDA(At, 0, 0); PG8_STAGE(PG8_SA(1, 1), a1 + hstepA, voffA);
            PG8_WAIT_V(8); PG8_WAIT_L(0); PG8_BAR; PG8_MMA(0, 0, At, B0); PG8_MMA(0, 1, At, B1); PG8_BAR; PG8_SCHED;
            PG8_LDA(At, 0, 1); PG8_STAGE(PG8_SB(0, 0), b2, voffB); PG8_STAGE(PG8_SB(0, 1), b2 + hstepB, voffB); PG8_STAGE(PG8_SA(0, 0), a2, voffA);
            PG8_WAIT_V(8); PG8_WAIT_L(0); PG8_BAR; PG8_MMA(1, 0, At, B0); PG8_MMA(1, 1, At, B1); PG8_BAR; PG8_SCHED;
            PG8_LDB(B0, 1, 0); PG8_LDB(B1, 1, 1); PG8_SCHED; PG8_LDA(At, 1, 0); PG8_STAGE(PG8_SA(0, 1), a2 + hstepA, voffA);
            PG8_WAIT_V(8); PG8_WAIT_L(0); PG8_BAR; PG8_MMA(0, 0, At, B0); PG8_MMA(0, 1, At, B1); PG8_BAR; PG8_SCHED;
            PG8_LDA(At, 1, 1); PG8_STAGE(PG8_SB(1, 0), b3, voffB); PG8_STAGE(PG8_SB(1, 1), b3 + hstepB, voffB); PG8_STAGE(PG8_SA(1, 0), a3, voffA);
            PG8_WAIT_V(8); PG8_WAIT_L(0); PG8_BAR; PG8_MMA(1, 0, At, B0); PG8_MMA(1, 1, At, B1); PG8_BAR; PG8_SCHED;
            } else {
            PG8_LDB(B0, 0, 0); PG8_SCHED; PG8_LDA(At, 0, 0); PG8_STAGE(PG8_SA(1, 1), a1 + hstepA, voffA);
            PG8_WAIT_L(8); PG8_BAR; PG8_WAIT_L(0); PG8_MMA(0, 0, At, B0); PG8_BAR; PG8_SCHED;
            PG8_LDB(B1, 0, 1); PG8_STAGE(PG8_SB(0, 0), b2, voffB);
            PG8_BAR; PG8_WAIT_L(0); PG8_MMA(0, 1, At, B1); PG8_BAR;
            PG8_LDA(At, 0, 1); PG8_STAGE(PG8_SA(0, 0), a2, voffA);
            PG8_BAR; PG8_WAIT_L(0); PG8_MMA(1, 0, At, B0); PG8_BAR; PG8_SCHED;
            PG8_STAGE(PG8_SB(0, 1), b2 + hstepB, voffB);
            PG8_WAIT_V(6); PG8_BAR; PG8_MMA(1, 1, At, B1); PG8_BAR;
            PG8_LDB(B0, 1, 0); PG8_SCHED; PG8_LDA(At, 1, 0); PG8_STAGE(PG8_SA(0, 1), a2 + hstepA, voffA);
            PG8_WAIT_L(8); PG8_BAR; PG8_WAIT_L(0); PG8_MMA(0, 0, At, B0); PG8_BAR; PG8_SCHED;
            PG8_LDB(B1, 1, 1); PG8_STAGE(PG8_SB(1, 0), b3, voffB);
            PG8_BAR; PG8_WAIT_L(0); PG8_MMA(0, 1, At, B1); PG8_BAR;
            PG8_LDA(At, 1, 1); PG8_STAGE(PG8_SA(1, 0), a3, voffA);
            PG8_BAR; PG8_WAIT_L(0); PG8_MMA(1, 0, At, B0); PG8_BAR; PG8_SCHED;
            PG8_STAGE(PG8_SB(1, 1), b3 + hstepB, voffB);
            PG8_WAIT_V(6); PG8_BAR; PG8_MMA(1, 1, At, B1); PG8_BAR;
            }
        }
        if constexpr (ALIGN_EPI) { if (wr == 0) PG8_BAR; }
        if constexpr (!Epi::AFTER_DRAIN) { E(acc, cur, wr, wc, fr, fq); S.done(cur); }
        if (!has_next) break;
#pragma unroll
        for (int a = 0; a < 2; ++a)
#pragma unroll
            for (int b = 0; b < 2; ++b)
#pragma unroll
                for (int m = 0; m < 4; ++m)
#pragma unroll
                    for (int n = 0; n < 2; ++n) acc[a][b][m][n] = (f32x4){0.f, 0.f, 0.f, 0.f};
        cur = nxt; cA = nA; cB = nB; ++ui;
        if constexpr (ALIGN_EPI) { if (wr == 1) PG8_BAR; }
    }
    PG8_WAIT_V(0);
    if constexpr (!ALIGN_EPI) { if (wr == 0) PG8_BAR; }
    PG8_BAR;
    if constexpr (Epi::AFTER_DRAIN) { E.fused(acc, cur, wr, wc, fr, fq, lds, wid, lane); S.done(cur); }
#undef PG8_SA
#undef PG8_SB
#undef PG8_STAGE
#undef PG8_LDA
#undef PG8_LDB
#undef PG8_MMA
#undef PG8_WAIT_V
#undef PG8_WAIT_L
#undef PG8_BAR
#undef PG8_SCHED
}
}
namespace att {
using bf16 = __hip_bfloat16;
using bf16x8 = __attribute__((ext_vector_type(8))) short;
using s16x4  = __attribute__((ext_vector_type(4))) short;
using f32x16 = __attribute__((ext_vector_type(16))) float;
using u32x4  = __attribute__((ext_vector_type(4))) unsigned;
using f32x4  = __attribute__((ext_vector_type(4))) float;
constexpr int NW = 8, QBLK = 32, KVBLK = 64;
constexpr float SCALE = 0.07216878364870323f;
constexpr float THR = 8.f;
constexpr int SDEPTH = ATT_SDEPTH;
constexpr int SHM_V = 16384, SHM_K = 24576;
constexpr int LDQ = NQ, LDK = NKV, LDP = NINP, LDO = DM;
constexpr int NQREG = ATT_NQREG, NQL = 12 - NQREG;
constexpr int SHM_QPE = 2 * SHM_V + 2 * SHM_K + NW * 64 * 4, SHM_ATTN = SHM_QPE + NW * NQL * 64 * 16;
static_assert(NQREG >= 8 && NQREG <= 12, "only rotary fragments are parked");
#define KSWZ(row, colB) ((row) * 384 + ((colB) ^ (((row) & 7) << 4)))
#define SBAR() __builtin_amdgcn_sched_barrier(0)
__device__ __forceinline__ int crow(int r, int hi) { return (r & 3) + 8 * (r >> 2) + 4 * hi; }
__device__ __forceinline__ unsigned cvtpk(float lo, float hi) { unsigned r; asm volatile("v_cvt_pk_bf16_f32 %0, %1, %2" : "=v"(r) : "v"(lo), "v"(hi)); return r; }
__device__ __forceinline__ float bf2f(short s) { return __uint_as_float(((unsigned)(unsigned short)s) << 16); }
__device__ __forceinline__ bf16x8 ld8(const bf16* p) { return *reinterpret_cast<const bf16x8*>(p); }
__device__ __forceinline__ bf16x8 scale8(bf16x8 v, float s) {
  u32x4 w = {cvtpk(bf2f(v[0]) * s, bf2f(v[1]) * s), cvtpk(bf2f(v[2]) * s, bf2f(v[3]) * s), cvtpk(bf2f(v[4]) * s, bf2f(v[5]) * s), cvtpk(bf2f(v[6]) * s, bf2f(v[7]) * s)};
  return *reinterpret_cast<bf16x8*>(&w);
}

__device__ __forceinline__ void partialSM(f32x16& p0, f32x16& p1, float& m_reg, float& mn, float& alpha) {
  constexpr float C = SCALE * 1.4426950408889634f;
  float pmax = p0[0]; for (int r = 1; r < 16; ++r) pmax = fmaxf(pmax, p0[r]); for (int r = 0; r < 16; ++r) pmax = fmaxf(pmax, p1[r]);
  { auto rr = __builtin_amdgcn_permlane32_swap(__float_as_uint(pmax), __float_as_uint(pmax), false, false);
    pmax = fmaxf(__uint_as_float(rr[0]), __uint_as_float(rr[1])); }
  if (__builtin_expect(__all(pmax - m_reg <= THR / SCALE), 1)) { mn = m_reg; alpha = 1.f; }
  else { mn = fmaxf(m_reg, pmax); alpha = __builtin_amdgcn_exp2f((m_reg - mn) * C); m_reg = mn; }
  float mnC = -mn * C;
  for (int r = 0; r < 16; ++r) p0[r] = fmaf(p0[r], C, mnC); for (int r = 0; r < 16; ++r) p1[r] = fmaf(p1[r], C, mnC);
  for (int r = 0; r < 16; ++r) p0[r] = __builtin_amdgcn_exp2f(p0[r]);
}
#define PK4(P, BASE, OUT) do { unsigned a0 = cvtpk(P[BASE + 0], P[BASE + 1]), a1 = cvtpk(P[BASE + 2], P[BASE + 3]);   \
    unsigned b0 = cvtpk(P[BASE + 4], P[BASE + 5]), b1 = cvtpk(P[BASE + 6], P[BASE + 7]);                              \
    auto r0 = __builtin_amdgcn_permlane32_swap(a0, b0, false, false); auto r1 = __builtin_amdgcn_permlane32_swap(a1, b1, false, false); \
    u32x4 w = {r0[0], r1[0], r0[1], r1[1]}; OUT = *reinterpret_cast<bf16x8*>(&w); } while (0)
__device__ __forceinline__ void finishSM(f32x16& p0, f32x16& p1, float alpha, float& l_reg, bf16x8& pa0, bf16x8& pa1, bf16x8& pa2, bf16x8& pa3) {
  for (int r = 0; r < 16; ++r) p1[r] = __builtin_amdgcn_exp2f(p1[r]);
  float ps = 0; for (int r = 0; r < 16; ++r) ps += p0[r]; for (int r = 0; r < 16; ++r) ps += p1[r];
  { auto rr = __builtin_amdgcn_permlane32_swap(__float_as_uint(ps), __float_as_uint(ps), false, false);
    ps = __uint_as_float(rr[0]) + __uint_as_float(rr[1]); }
  l_reg = l_reg * alpha + ps;
  PK4(p0, 0, pa0); PK4(p0, 8, pa1); PK4(p1, 0, pa2); PK4(p1, 8, pa3);
}
__device__ __forceinline__ void qkt(f32x16& p0, f32x16& p1, const bf16* Ks, const bf16x8* qr, const bf16x8* qpe, int r32, int hi) {
  p0 = f32x16{}; p1 = f32x16{};
#pragma unroll
  for (int d0 = 0; d0 < 12; ++d0) { int cb = (d0 * 16 + hi * 8) * 2;
    bf16x8 b0 = *reinterpret_cast<const bf16x8*>((const char*)Ks + KSWZ(r32, cb));
    bf16x8 b1 = *reinterpret_cast<const bf16x8*>((const char*)Ks + KSWZ(32 + r32, cb));
    const bf16x8 qf = d0 < NQREG ? qr[d0 < NQREG ? d0 : 0] : qpe[(d0 < NQREG ? 0 : d0 - NQREG) * 64];
    p0 = __builtin_amdgcn_mfma_f32_32x32x16_bf16(b0, qf, p0, 0, 0, 0);
    p1 = __builtin_amdgcn_mfma_f32_32x32x16_bf16(b1, qf, p1, 0, 0, 0); }
}
__device__ __forceinline__ int v_st(int k, int c) { const int kk = (k & ~0xC) | ((k & 4) << 1) | ((k & 8) >> 1); return ((kk >> 3) * 4 + (c >> 5)) * 512 + ((kk & 7) * 32 + (c & 31)) * 2; }
__device__ __forceinline__ int v_rd_base(int lane) { return ((lane & 3) << 3) | (((lane >> 2) & 3) << 6) | (((lane >> 4) & 1) << 5) | (((lane >> 5) & 1) << 8); }
constexpr int v_rd_off(int d0, int ks, int half) { return d0 * 512 + ks * 4096 + half * 2048; }
template <int OFF> __device__ __forceinline__ s16x4 tr_read(int vb) {
  s16x4 r; asm volatile("ds_read_b64_tr_b16 %0, %1 offset:%2" : "=&v"(r) : "v"(vb), "i"(OFF) : "memory"); return r;
}
#define PKF(L, H) (bf16x8){L[0], L[1], L[2], L[3], H[0], H[1], H[2], H[3]}
template <int D0> __device__ __forceinline__ void pv_one(f32x16& od, int vb, bf16x8 pa0, bf16x8 pa1, bf16x8 pa2, bf16x8 pa3) {
  const s16x4 l0 = tr_read<v_rd_off(D0, 0, 0)>(vb), h0 = tr_read<v_rd_off(D0, 0, 1)>(vb), l1 = tr_read<v_rd_off(D0, 1, 0)>(vb), h1 = tr_read<v_rd_off(D0, 1, 1)>(vb);
  const s16x4 l2 = tr_read<v_rd_off(D0, 2, 0)>(vb), h2 = tr_read<v_rd_off(D0, 2, 1)>(vb), l3 = tr_read<v_rd_off(D0, 3, 0)>(vb), h3 = tr_read<v_rd_off(D0, 3, 1)>(vb);
  asm volatile("s_waitcnt lgkmcnt(0)" ::: "memory"); SBAR();
  od = __builtin_amdgcn_mfma_f32_32x32x16_bf16(pa0, PKF(l0, h0), od, 0, 0, 0);
  od = __builtin_amdgcn_mfma_f32_32x32x16_bf16(pa1, PKF(l1, h1), od, 0, 0, 0);
  od = __builtin_amdgcn_mfma_f32_32x32x16_bf16(pa2, PKF(l2, h2), od, 0, 0, 0);
  od = __builtin_amdgcn_mfma_f32_32x32x16_bf16(pa3, PKF(l3, h3), od, 0, 0, 0);
}
__device__ __forceinline__ void pv_d0(f32x16* o, int vb, bf16x8 pa0, bf16x8 pa1, bf16x8 pa2, bf16x8 pa3) {
  pv_one<0>(o[0], vb, pa0, pa1, pa2, pa3); pv_one<1>(o[1], vb, pa0, pa1, pa2, pa3); pv_one<2>(o[2], vb, pa0, pa1, pa2, pa3); pv_one<3>(o[3], vb, pa0, pa1, pa2, pa3);
}
__device__ __forceinline__ void attn_body(const bf16* __restrict__ Qb, const bf16* __restrict__ Kh, const bf16* __restrict__ Vh, const bf16* __restrict__ Pe,
                                          bf16* __restrict__ Ob, const float* __restrict__ ropeq, const float* __restrict__ ssqq, int seq, char* lds) {
  int tid_ = threadIdx.x; asm volatile("" : "+v"(tid_));
  const int tid = tid_, wid = tid >> 6, lane = tid & 63, r32 = lane & 31, hi = lane >> 5;
  bf16* V_lds = (bf16*)lds; bf16* K_lds = (bf16*)(lds + 2 * SHM_V);
  float* ws = (float*)(lds + 2 * SHM_V + 2 * SHM_K) + wid * 64; float* li_l = ws; float* al_l = ws + 32;
  float m_reg = -1e30f, l_reg = 0; f32x16 o[4] = {}; bf16x8 qr[NQREG]; bf16x8* qpe = (bf16x8*)(lds + SHM_QPE) + wid * (NQL * 64) + lane;
  const bf16* Qw = Qb + (long)(wid * QBLK + r32) * LDQ + hi * 8;
  float qrs; { const float* s = ssqq + (long)(wid * QBLK + r32) * 24; const f32x4 a = *(const f32x4*)s, b = *(const f32x4*)(s + 4), c = *(const f32x4*)(s + 8);
    qrs = rsqrtf((((a[0] + a[1]) + (a[2] + a[3])) + ((b[0] + b[1]) + (b[2] + b[3])) + ((c[0] + c[1]) + (c[2] + c[3]))) * (1.f / QL) + EPS); }
#pragma unroll
  for (int d0 = 0; d0 < 8; ++d0) qr[d0] = scale8(ld8(Qw + d0 * 16), qrs);
  { const float* rp = ropeq + ((long)(wid * QBLK + r32) * 32 + hi * 4) * 2;
#pragma unroll
    for (int d0 = 0; d0 < 4; ++d0) { const bf16x8 raw = ld8(Qw + (8 + d0) * 16); const f32x4 ca = *(const f32x4*)(rp + d0 * 16), cb_ = *(const f32x4*)(rp + d0 * 16 + 4);
      const float x0 = bf2f(raw[0]) * qrs, x1 = bf2f(raw[1]) * qrs, x2 = bf2f(raw[2]) * qrs, x3 = bf2f(raw[3]) * qrs, x4 = bf2f(raw[4]) * qrs, x5 = bf2f(raw[5]) * qrs, x6 = bf2f(raw[6]) * qrs, x7 = bf2f(raw[7]) * qrs;
      u32x4 w = {cvtpk(x0 * ca[0] - x1 * ca[1], x1 * ca[0] + x0 * ca[1]), cvtpk(x2 * ca[2] - x3 * ca[3], x3 * ca[2] + x2 * ca[3]),
                 cvtpk(x4 * cb_[0] - x5 * cb_[1], x5 * cb_[0] + x4 * cb_[1]), cvtpk(x6 * cb_[2] - x7 * cb_[3], x7 * cb_[2] + x6 * cb_[3])};
      if (8 + d0 < NQREG) qr[8 + d0 < NQREG ? 8 + d0 : 0] = *reinterpret_cast<bf16x8*>(&w); else qpe[(8 + d0 < NQREG ? 0 : 8 + d0 - NQREG) * 64] = *reinterpret_cast<bf16x8*>(&w); } }
  const int sr = tid >> 4, sc = (tid & 15) * 8, vst0 = v_st(sr, sc), vst1 = v_st(32 + sr, sc);
  const int pr = tid >> 3, pc = (tid & 7) * 8;
  const int vb0 = (int)(uintptr_t)V_lds + v_rd_base(lane);
  struct { bf16x8 vs0, vs1, ks0, ks1, kp; } sr_[SDEPTH];
#define SLOAD(i, k0) do { sr_[i].vs0 = ld8(&Vh[(long)((k0) + sr) * LDK + sc]); sr_[i].vs1 = ld8(&Vh[(long)((k0) + 32 + sr) * LDK + sc]); \
    sr_[i].ks0 = ld8(&Kh[(long)((k0) + sr) * LDK + sc]); sr_[i].ks1 = ld8(&Kh[(long)((k0) + 32 + sr) * LDK + sc]); sr_[i].kp = ld8(&Pe[(long)((k0) + pr) * LDP + pc]); } while (0)
#define SWRITE(b, i) do { *(bf16x8*)((char*)V_lds + (b) * SHM_V + vst0) = sr_[i].vs0;          \
    *(bf16x8*)((char*)V_lds + (b) * SHM_V + vst1) = sr_[i].vs1; int kc = sc * 2;               \
    *(bf16x8*)((char*)K_lds + (b) * SHM_K + KSWZ(sr, kc)) = sr_[i].ks0;                       \
    *(bf16x8*)((char*)K_lds + (b) * SHM_K + KSWZ(32 + sr, kc)) = sr_[i].ks1;                  \
    *(bf16x8*)((char*)K_lds + (b) * SHM_K + KSWZ(pr, 256 + pc * 2)) = sr_[i].kp; } while (0)
#define SWAIT() do { if constexpr (SDEPTH == 2) asm volatile("s_waitcnt vmcnt(5)" ::: "memory"); else asm volatile("s_waitcnt vmcnt(0)" ::: "memory"); } while (0)
#define RESC(a) do { if (__any((a) < 1.f)) { if (hi == 0) al_l[r32] = (a); asm volatile("s_waitcnt lgkmcnt(0)" ::: "memory"); \
    for (int d = 0; d < 4; ++d) for (int r = 0; r < 16; ++r) o[d][r] *= al_l[crow(r, hi)]; } } while (0)
  f32x16 pA0, pA1, pB0, pB1; float mnA, mnB, alA, alB; bf16x8 pa0, pa1, pa2, pa3; const int NT = seq / KVBLK;
  constexpr int SE = 0, SO = SDEPTH - 1;
  SLOAD(SE, 0); asm volatile("s_waitcnt vmcnt(0)" ::: "memory"); SWRITE(0, SE); __syncthreads();
  qkt(pA0, pA1, K_lds, qr, qpe, r32, hi); partialSM(pA0, pA1, m_reg, mnA, alA);
  SLOAD(SO, KVBLK); if constexpr (SDEPTH == 2) { if (2 < NT) SLOAD(SE, 2 * KVBLK); }
  SWAIT(); SWRITE(1, SO); __syncthreads();
  for (int j = 1; j + 1 < NT; j += 2) {
    SBAR(); qkt(pB0, pB1, (bf16*)((char*)K_lds + SHM_K), qr, qpe, r32, hi);
    finishSM(pA0, pA1, alA, l_reg, pa0, pa1, pa2, pa3); SBAR();
    SLOAD(SO, (j + SDEPTH) * KVBLK); SBAR();
    pv_d0(o, vb0, pa0, pa1, pa2, pa3); partialSM(pB0, pB1, m_reg, mnB, alB);
    __syncthreads(); SWAIT(); SWRITE(0, SE);
    RESC(alB); __syncthreads();
    SBAR(); qkt(pA0, pA1, K_lds, qr, qpe, r32, hi);
    finishSM(pB0, pB1, alB, l_reg, pa0, pa1, pa2, pa3); SBAR();
    if (SDEPTH == 1 || j + 3 < NT) SLOAD(SE, (j + 1 + SDEPTH) * KVBLK); SBAR();
    pv_d0(o, vb0 + (int)SHM_V, pa0, pa1, pa2, pa3); partialSM(pA0, pA1, m_reg, mnA, alA);
    __syncthreads(); SWAIT(); SWRITE(1, SO);
    RESC(alA); __syncthreads();
  }
  SBAR(); qkt(pB0, pB1, (bf16*)((char*)K_lds + SHM_K), qr, qpe, r32, hi);
  finishSM(pA0, pA1, alA, l_reg, pa0, pa1, pa2, pa3); SBAR();
  pv_d0(o, vb0, pa0, pa1, pa2, pa3); partialSM(pB0, pB1, m_reg, mnB, alB);
  __syncthreads(); RESC(alB);
  finishSM(pB0, pB1, alB, l_reg, pa0, pa1, pa2, pa3); SBAR();
  pv_d0(o, vb0 + (int)SHM_V, pa0, pa1, pa2, pa3);
  if (hi == 0) li_l[r32] = l_reg; asm volatile("s_waitcnt lgkmcnt(0)" ::: "memory");
  float rli[16];
#pragma unroll
  for (int r = 0; r < 16; ++r) rli[r] = __builtin_amdgcn_rcpf(li_l[crow(r, hi)]);
  bf16* Ow = Ob + (long)(wid * QBLK) * LDO;
#pragma unroll
  for (int r = 0; r < 16; ++r) { int orow = crow(r, hi);
    for (int d0 = 0; d0 < 4; ++d0) Ow[(long)orow * LDO + d0 * 32 + r32] = __float2bfloat16(o[d0][r] * rli[r]); }
  __syncthreads();
#undef SLOAD
#undef SWRITE
#undef SWAIT
#undef RESC
}

__device__ __forceinline__ void ret_states(int item, const bf16* __restrict__ P, bf16* __restrict__ St, const float* dec_f, const float* dec_b, char* lds) {
  int tid_ = threadIdx.x; asm volatile("" : "+v"(tid_));
  const int tid = tid_, wid = tid >> 6, lane = tid & 63, r32 = lane & 31, hi = lane >> 5;
  const int b = item >> 3, h = (item >> 1) & 3, dir = item & 1;
  const float dl = (dir ? dec_b : dec_f)[h];
  const float l2 = -log1pf(expf(-dl)) * 1.4426950408889634f;
  const float decay128 = exp2f(l2 * 128.f);
  char* Kimg = lds; char* Vimg = lds + 32768;
  const int db = wid & 1, vbk = wid >> 1;
  f32x16 acc = {};
  bf16x8 kreg[2], vreg[4]; int koff[2], voff[4]; float kw[2];
#pragma unroll
  for (int q = 0; q < 2; ++q) { const int c = tid + 512 * q, row = c >> 3, col = (c & 7) * 8; koff[q] = (row >> 6) * 16384 + v_st(row & 63, col); kw[q] = exp2f(l2 * (float)(dir ? row : 127 - row)); }
#pragma unroll
  for (int q = 0; q < 4; ++q) { const int c = tid + 512 * q, row = c >> 4, col = (c & 15) * 8; voff[q] = (row >> 6) * 16384 + v_st(row & 63, col); }
  const int ka = (int)(uintptr_t)Kimg + v_rd_base(lane) + db * 512, va = (int)(uintptr_t)Vimg + v_rd_base(lane) + vbk * 512;
#define R1_ROWBASE(s) (b * TOK + (dir == 0 ? ((s) < 2 ? (s) * 128 : 256 + ((s) - 2) * 128) : ((s) < 2 ? (1 - (s)) * 128 : 256 + (17 - (s)) * 128)))
#define R1_LOAD(s) do { const long rb = R1_ROWBASE(s); \
    _Pragma("unroll") for (int q = 0; q < 2; ++q) { const int c = tid + 512 * q; kreg[q] = ld8(P + (rb + (c >> 3)) * LDP + C_RK + h * 64 + (c & 7) * 8); } \
    _Pragma("unroll") for (int q = 0; q < 4; ++q) { const int c = tid + 512 * q; vreg[q] = ld8(P + (rb + (c >> 4)) * LDP + C_RV + h * 128 + (c & 15) * 8); } } while (0)
#define R1_STORE(n) do { bf16* dst = St + ((long)((b * 4 + h) * 16 + (n)) * 128 + dir * 64 + db * 32) * 128 + vbk * 32 + r32; \
    _Pragma("unroll") for (int r = 0; r < 16; ++r) dst[crow(r, hi) * 128] = __float2bfloat16(acc[r]); } while (0)
  R1_LOAD(0);
  for (int s = 0; s < 17; ++s) {
#pragma unroll
    for (int q = 0; q < 2; ++q) *(bf16x8*)(Kimg + koff[q]) = scale8(kreg[q], kw[q]);
#pragma unroll
    for (int q = 0; q < 4; ++q) *(bf16x8*)(Vimg + voff[q]) = vreg[q];
    __syncthreads();
    if (s + 1 < 17) R1_LOAD(s + 1);
    if (s >= 2) { const int n = dir == 0 ? s - 2 : 17 - s; R1_STORE(n); }
#pragma unroll
    for (int r = 0; r < 16; ++r) acc[r] *= decay128;
    { s16x4 al[8], ah[8], bl[8], bh[8];
#define R1_RD(I, KT, KS) al[I] = tr_read<(KT) * 16384 + v_rd_off(0, KS, 0)>(ka); ah[I] = tr_read<(KT) * 16384 + v_rd_off(0, KS, 1)>(ka); bl[I] = tr_read<(KT) * 16384 + v_rd_off(0, KS, 0)>(va); bh[I] = tr_read<(KT) * 16384 + v_rd_off(0, KS, 1)>(va)
      R1_RD(0, 0, 0); R1_RD(1, 0, 1); R1_RD(2, 0, 2); R1_RD(3, 0, 3); R1_RD(4, 1, 0); R1_RD(5, 1, 1); R1_RD(6, 1, 2); R1_RD(7, 1, 3);
      asm volatile("s_waitcnt lgkmcnt(0)" ::: "memory"); SBAR();
      f32x16 acc2 = {};
#pragma unroll
      for (int I = 0; I < 8; I += 2) { acc = __builtin_amdgcn_mfma_f32_32x32x16_bf16(PKF(al[I], ah[I]), PKF(bl[I], bh[I]), acc, 0, 0, 0);
        acc2 = __builtin_amdgcn_mfma_f32_32x32x16_bf16(PKF(al[I + 1], ah[I + 1]), PKF(bl[I + 1], bh[I + 1]), acc2, 0, 0, 0); }
#pragma unroll
      for (int r = 0; r < 16; ++r) acc[r] += acc2[r]; }
    __syncthreads();
  }
  { const int n = dir == 0 ? 15 : 0; R1_STORE(n); }
#undef R1_RD
#undef R1_LOAD
#undef R1_STORE
#undef R1_ROWBASE
}
template <int DV2> __device__ __forceinline__ void pv_two(f32x16* o, int vb, bf16x8 pa0, bf16x8 pa1, bf16x8 pa2, bf16x8 pa3) {
  pv_one<0>(o[0], vb, pa0, pa1, pa2, pa3); pv_one<1>(o[1], vb, pa0, pa1, pa2, pa3);
}
__device__ __forceinline__ void ret_chunk(int b, int h, int n, const bf16* __restrict__ P, const bf16* __restrict__ St, const float* __restrict__ g_ret,
                                          float l2f, float l2b, bf16* __restrict__ Y, char* lds) {
  int tid_ = threadIdx.x; asm volatile("" : "+v"(tid_));
  const int tid = tid_, wid = tid >> 6, lane = tid & 63, r32 = lane & 31, hi = lane >> 5, wq = wid & 3, dvh = wid >> 2;
  char* Kt = lds; char* Vimg = lds + 16384; char* Simg = lds + 49152; float* Ot = (float*)lds;
  const long rowbase = (long)b * TOK + 256 + n * 128;
  bf16x8 qr[4];
  { const bf16* qp = P + (rowbase + 32 * wq + r32) * LDP + C_RQ + h * 64 + hi * 8;
#pragma unroll
    for (int d0 = 0; d0 < 4; ++d0) qr[d0] = ld8(qp + d0 * 16); }
#define KS128(row, colB) ((row) * 128 + ((colB) ^ (((row) & 7) << 4)))
  { bf16x8 kreg[2], vreg[4], sreg[4];
#pragma unroll
    for (int q = 0; q < 2; ++q) { const int c = tid + 512 * q; kreg[q] = ld8(P + (rowbase + (c >> 3)) * LDP + C_RK + h * 64 + (c & 7) * 8); }
#pragma unroll
    for (int q = 0; q < 4; ++q) { const int c = tid + 512 * q; vreg[q] = ld8(P + (rowbase + (c >> 4)) * LDP + C_RV + h * 128 + (c & 15) * 8);
      sreg[q] = ld8(St + ((long)((b * 4 + h) * 16 + n) * 128 + (c >> 4)) * 128 + (c & 15) * 8); }
#pragma unroll
    for (int q = 0; q < 2; ++q) { const int c = tid + 512 * q, row = c >> 3, col = (c & 7) * 8; *(bf16x8*)(Kt + KS128(row, col * 2)) = kreg[q]; }
#pragma unroll
    for (int q = 0; q < 4; ++q) { const int c = tid + 512 * q, row = c >> 4, col = (c & 15) * 8, off = (row >> 6) * 16384 + v_st(row & 63, col);
      *(bf16x8*)(Vimg + off) = vreg[q]; *(bf16x8*)(Simg + off) = sreg[q]; } }
  __syncthreads();
  f32x16 o[2] = {};
  const int i = 32 * wq + r32;
  const int vb = (int)(uintptr_t)Vimg + v_rd_base(lane) + dvh * 1024, sb = (int)(uintptr_t)Simg + v_rd_base(lane) + dvh * 1024;
#pragma nounroll
  for (int kt = 0; kt < 2; ++kt) {
    f32x16 p0 = {}, p1 = {};
#pragma unroll
    for (int d0 = 0; d0 < 4; ++d0) { const int cb = (d0 * 16 + hi * 8) * 2;
      const bf16x8 b0 = *reinterpret_cast<const bf16x8*>(Kt + KS128(64 * kt + r32, cb)), b1 = *reinterpret_cast<const bf16x8*>(Kt + KS128(64 * kt + 32 + r32, cb));
      p0 = __builtin_amdgcn_mfma_f32_32x32x16_bf16(b0, qr[d0], p0, 0, 0, 0); p1 = __builtin_amdgcn_mfma_f32_32x32x16_bf16(b1, qr[d0], p1, 0, 0, 0); }
#pragma unroll
    for (int r = 0; r < 16; ++r) { const int d0_ = i - (64 * kt + crow(r, hi)), d1_ = d0_ - 32;
      const float a0 = d0_ > 0 ? l2f * (float)d0_ : l2b * (float)(-d0_), a1 = d1_ > 0 ? l2f * (float)d1_ : l2b * (float)(-d1_);
      const float m0 = __builtin_amdgcn_exp2f(a0) * (d0_ == 0 ? 2.f : 1.f), m1 = __builtin_amdgcn_exp2f(a1) * (d1_ == 0 ? 2.f : 1.f);
      p0[r] *= m0; p1[r] *= m1; }
    bf16x8 pa0, pa1, pa2, pa3; PK4(p0, 0, pa0); PK4(p0, 8, pa1); PK4(p1, 0, pa2); PK4(p1, 8, pa3);
    pv_two<0>(o, vb + kt * 16384, pa0, pa1, pa2, pa3);
  }
  { const float sf = __builtin_amdgcn_exp2f(l2f * (float)(i + 1)), sbw = __builtin_amdgcn_exp2f(l2b * (float)(128 - i));
    pv_two<0>(o, sb, scale8(qr[0], sf), scale8(qr[1], sf), scale8(qr[2], sf), scale8(qr[3], sf));
    pv_two<0>(o, sb + 16384, scale8(qr[0], sbw), scale8(qr[1], sbw), scale8(qr[2], sbw), scale8(qr[3], sbw)); }
  __syncthreads();
#pragma unroll
  for (int d = 0; d < 2; ++d)
#pragma unroll
    for (int r = 0; r < 16; ++r) Ot[(32 * wq + crow(r, hi)) * 132 + 64 * dvh + 32 * d + r32] = o[d][r];
  __syncthreads();
  { const int row = tid >> 2, qd = tid & 3; const float* op = Ot + row * 132 + qd * 32;
    f32x4 v[8]; float s = 0.f;
#pragma unroll
    for (int j = 0; j < 8; ++j) { v[j] = *(const f32x4*)(op + 4 * j); s += (v[j][0] + v[j][1]) + (v[j][2] + v[j][3]); }
    s += __shfl_xor(s, 1); s += __shfl_xor(s, 2); const float mu = s * (1.f / 128.f); float q2 = 0.f;
#pragma unroll
    for (int j = 0; j < 8; ++j) { v[j] = v[j] - mu; q2 += (v[j][0] * v[j][0] + v[j][1] * v[j][1]) + (v[j][2] * v[j][2] + v[j][3] * v[j][3]); }
    q2 += __shfl_xor(q2, 1); q2 += __shfl_xor(q2, 2); const float rstd = rsqrtf(q2 * (1.f / 128.f) + EPS);
    const bf16* gp = P + (rowbase + row) * LDP + C_RG + h * 128 + qd * 32; const float* grp = g_ret + h * 128 + qd * 32;
    bf16* yp = Y + ((long)b * SEQ + n * 128 + row) * DM + h * 128 + qd * 32;
#pragma unroll
    for (int j = 0; j < 4; ++j) { const bf16x8 g8 = ld8(gp + 8 * j); const f32x4 ga = *(const f32x4*)(grp + 8 * j), gb = *(const f32x4*)(grp + 8 * j + 4); float y[8];
#pragma unroll
      for (int e = 0; e < 8; ++e) { const float gt = bf2f(g8[e]), sg = gt / (1.f + __expf(-gt)); const float ov = e < 4 ? v[2 * j][e] * ga[e] : v[2 * j + 1][e - 4] * gb[e - 4]; y[e] = ov * rstd * sg; }
      u32x4 w = {cvtpk(y[0], y[1]), cvtpk(y[2], y[3]), cvtpk(y[4], y[5]), cvtpk(y[6], y[7])}; *(u32x4*)(yp + 8 * j) = w; } }
  __syncthreads();
#undef KS128
}
#undef KSWZ
#undef SBAR
#undef PK4
#undef PKF
}
#define LAS __attribute__((address_space(3)))
typedef unsigned short bf16r;
typedef unsigned v4u __attribute__((ext_vector_type(4)));
typedef float f32x4 __attribute__((ext_vector_type(4)));
__device__ __forceinline__ unsigned f2bf(float f) { unsigned u = __builtin_bit_cast(unsigned, f); return (u + 0x7fffu + ((u >> 16) & 1u)) >> 16; }
__device__ __forceinline__ unsigned pk2(float lo, float hi) { return f2bf(lo) | (f2bf(hi) << 16); }
__device__ __forceinline__ float wave_sum(float v) {
#pragma unroll
    for (int o = 1; o < 64; o <<= 1) v += __shfl_xor(v, o);
    return v;
}
__device__ __forceinline__ int ileave64(int n) { const int d = n & 63; return (n & ~63) + (d < 32 ? 2 * d : 2 * (d - 32) + 1); }
template <int MAP> __device__ __forceinline__ int colmap(int n) {
    if (MAP == 1) return (n < 512 || n >= C_KPE) ? ileave64(n) : n;
    if (MAP == 2) { const int w = n % 192; return w >= 128 ? (n - w) + 128 + ileave64(w - 128) : n; }
    return n;
}
template <int MAP> __device__ __forceinline__ void transpose_item(const float* __restrict__ W, int K, int N, bf16r* __restrict__ WT, const float* __restrict__ kscale, float* scr, int item, int lane) {
    const int nblk = N / 32, kb = item / nblk, nb = item % nblk, k0 = 64 * kb, n0 = 32 * nb;
#pragma unroll 8
    for (int i = 0; i < 32; ++i) { const int kk = 2 * i + (lane >> 5); float v = W[(size_t)(k0 + kk) * N + n0 + (lane & 31)]; if (kscale) v *= kscale[k0 + kk]; scr[kk * 33 + (lane & 31)] = v; }
    asm volatile("s_waitcnt lgkmcnt(0)" ::: "memory");
    const int c = lane & 7;
#pragma unroll
    for (int j = 0; j < 4; ++j) { const int n = (lane >> 3) + 8 * j; const float* s = scr + (8 * c) * 33 + n;
        v4u o; o.x = pk2(s[0 * 33], s[1 * 33]); o.y = pk2(s[2 * 33], s[3 * 33]); o.z = pk2(s[4 * 33], s[5 * 33]); o.w = pk2(s[6 * 33], s[7 * 33]);
        *(v4u*)(WT + (size_t)colmap<MAP>(n0 + n) * K + k0 + 8 * c) = o; }
    asm volatile("s_waitcnt lgkmcnt(0)" ::: "memory");
}
__device__ __forceinline__ void norm_mod_row(const float* __restrict__ xrow, const float* __restrict__ g, const float* __restrict__ sh, const float* __restrict__ sc, bf16r* __restrict__ orow, int lane) {
    const f32x4* xr = (const f32x4*)xrow + lane; f32x4 v[4]; float s = 0.f;
#pragma unroll
    for (int j = 0; j < 4; ++j) { v[j] = xr[64 * j]; s += (v[j][0] * v[j][0] + v[j][1] * v[j][1]) + (v[j][2] * v[j][2] + v[j][3] * v[j][3]); }
    const float rstd = rsqrtf(wave_sum(s) * (1.f / DM) + EPS);
    unsigned long long* o8 = (unsigned long long*)orow + lane;
#pragma unroll
    for (int j = 0; j < 4; ++j) { const f32x4 gg = ((const f32x4*)g)[lane + 64 * j], hh = ((const f32x4*)sh)[lane + 64 * j], cc = ((const f32x4*)sc)[lane + 64 * j];
        const f32x4 y = (v[j] * rstd * gg) * (cc + 1.f) + hh;
        o8[64 * j] = (unsigned long long)pk2(y[0], y[1]) | ((unsigned long long)pk2(y[2], y[3]) << 32); }
}

#define RLX_AGENT __ATOMIC_RELAXED, __HIP_MEMORY_SCOPE_AGENT
#define XB_TMO      128
#define XB_XCNT(j)  (256  + 64 * (j))
#define XB_XSUB(j)  (1280 + 64 * (j))
#define XB_XGEN(j)  (2304 + 64 * (j))
#define XB_TOP      3328
#define XB_TOPGEN   3392
#define XCD_BAR_WORDS 3456
#define XB_SPIN_CAP (1u << 18)

__device__ __forceinline__ unsigned xb_ld(unsigned* p)              { return __hip_atomic_load(p, __ATOMIC_RELAXED, __HIP_MEMORY_SCOPE_AGENT); }
__device__ __forceinline__ unsigned xb_add(unsigned* p, unsigned v) { return __hip_atomic_fetch_add(p, v, __ATOMIC_RELAXED, __HIP_MEMORY_SCOPE_AGENT); }
__device__ __forceinline__ unsigned xb_xcc_id() { return (unsigned)__builtin_amdgcn_s_getreg((3 << 11) | 20) & 0xFu; }
#define XB_SPIN(cond, bar) do { unsigned _sp = 0; while (cond) { __builtin_amdgcn_s_sleep(1); \
    if ((++_sp & 255u) == 0u) { if (xb_ld(&(bar)[XB_TMO])) break; if (_sp > XB_SPIN_CAP) { atomicAdd(&(bar)[XB_TMO], 1u); break; } } } } while (0)

struct XcdBarrier {
    unsigned* bar; unsigned x;
    volatile LAS unsigned* st;
};

__device__ __forceinline__ XcdBarrier xcd_barrier_post(unsigned* bar, volatile LAS unsigned* st) {
    XcdBarrier b; b.bar = bar; b.x = xb_xcc_id(); b.st = st;
    if (threadIdx.x == 0) (void)xb_add(&bar[XB_XCNT(b.x)], 1u);
    return b;
}
__device__ __forceinline__ void xcd_barrier_complete(unsigned* bar, unsigned x, unsigned& nloc, unsigned& nx) {
    const unsigned G = gridDim.x * gridDim.y * gridDim.z;
    unsigned sum, cnt, mine, sp = 0u;
    for (;;) {
        sum = 0u; cnt = 0u; mine = 0u;
#pragma unroll
        for (unsigned j = 0; j < 16; ++j) { const unsigned c = xb_ld(&bar[XB_XCNT(j)]); sum += c; cnt += (c > 0u) ? 1u : 0u; mine = (j == x) ? c : mine; }
        if (sum == G) break;
        __builtin_amdgcn_s_sleep(1);
        if ((++sp & 255u) == 0u) { if (xb_ld(&bar[XB_TMO])) break; if (sp > XB_SPIN_CAP) { atomicAdd(&bar[XB_TMO], 1u); break; } }
    }
    nloc = mine > 0u ? mine : 1u; nx = cnt > 0u ? cnt : 1u;
}

__device__ __forceinline__ void xcd_barrier(const XcdBarrier& b) {
    asm volatile("s_waitcnt vmcnt(0)" ::: "memory");
    __syncthreads();
    if (threadIdx.x == 0) {
        unsigned* bar = b.bar;
        __builtin_amdgcn_s_waitcnt(0);
        unsigned nloc = b.st[0], nx = b.st[1];
        if (nloc == 0u) { xcd_barrier_complete(bar, b.x, nloc, nx); b.st[0] = nloc; b.st[1] = nx; }
        const unsigned old = xb_add(&bar[XB_XSUB(b.x)], 1u);
        const unsigned gen = old / nloc;
        if (old + 1u == (gen + 1u) * nloc) {
            __builtin_amdgcn_fence(__ATOMIC_RELEASE, "agent");
            asm volatile("s_waitcnt vmcnt(0)" ::: "memory");
            const unsigned og = xb_add(&bar[XB_TOP], 1u);
            const unsigned tg = og / nx;
            if (og + 1u == (tg + 1u) * nx) xb_add(&bar[XB_TOPGEN], 1u);
            else XB_SPIN(xb_ld(&bar[XB_TOPGEN]) == tg, bar);
            __builtin_amdgcn_fence(__ATOMIC_ACQUIRE, "agent");
            xb_add(&bar[XB_XGEN(b.x)], 1u);
            asm volatile("s_waitcnt vmcnt(0)" ::: "memory");
        } else {
            XB_SPIN(xb_ld(&bar[XB_XGEN(b.x)]) == gen, bar);
            __builtin_amdgcn_fence(__ATOMIC_ACQUIRE, "agent");
            asm volatile("s_waitcnt vmcnt(0)" ::: "memory");
        }
    }
    __syncthreads();
}

#define LAUNDER_V(x) asm volatile("" : "+v"(x))
#define LAUNDER_S(x) asm volatile("" : "+s"(x))
#ifdef PROBE_SYNC2
#define GSYNC() do { xcd_barrier(xbar); xcd_barrier(xbar); } while (0)
#else
#define GSYNC() xcd_barrier(xbar)
#endif
#ifndef PROBE_P0_REP
#define PROBE_P0_REP 1
#endif
#ifndef PROBE_P1_REP
#define PROBE_P1_REP 1
#endif
#ifndef PROBE_P2_REP
#define PROBE_P2_REP 1
#endif
#ifndef PROBE_P3G_REP
#define PROBE_P3G_REP 1
#endif
#ifndef PROBE_P5_REP
#define PROBE_P5_REP 1
#endif
#ifndef PROBE_P6_REP
#define PROBE_P6_REP 1
#endif
#ifndef PROBE_P7_REP
#define PROBE_P7_REP 1
#endif
#ifndef PROBE_ATT_REP
#define PROBE_ATT_REP 1
#endif
#ifndef PROBE_R1_REP
#define PROBE_R1_REP 1
#endif
#ifndef PROBE_RET_REP
#define PROBE_RET_REP 1
#endif
__device__ __forceinline__ void norm_mod_row_bf(const bf16r* __restrict__ xrow, const float* __restrict__ g, const float* __restrict__ sh, const float* __restrict__ sc, bf16r* __restrict__ orow, int lane) {
    float v[2][8]; float s = 0.f;
#pragma unroll
    for (int j = 0; j < 2; ++j) { const v4u w = *(const v4u*)(xrow + 8 * lane + 512 * j);
        v[j][0] = __uint_as_float(w.x << 16); v[j][1] = __uint_as_float(w.x & 0xffff0000u); v[j][2] = __uint_as_float(w.y << 16); v[j][3] = __uint_as_float(w.y & 0xffff0000u);
        v[j][4] = __uint_as_float(w.z << 16); v[j][5] = __uint_as_float(w.z & 0xffff0000u); v[j][6] = __uint_as_float(w.w << 16); v[j][7] = __uint_as_float(w.w & 0xffff0000u);
#pragma unroll
        for (int e = 0; e < 8; ++e) s += v[j][e] * v[j][e]; }
    const float rstd = rsqrtf(wave_sum(s) * (1.f / DM) + EPS);
#pragma unroll
    for (int j = 0; j < 2; ++j) { const int c0 = 8 * lane + 512 * j; float y[8];
#pragma unroll
        for (int h = 0; h < 2; ++h) { const f32x4 gg = *(const f32x4*)(g + c0 + 4 * h), hh = *(const f32x4*)(sh + c0 + 4 * h), cc = *(const f32x4*)(sc + c0 + 4 * h);
#pragma unroll
            for (int e = 0; e < 4; ++e) y[4 * h + e] = (v[j][4 * h + e] * rstd * gg[e]) * (cc[e] + 1.f) + hh[e]; }
        v4u o; o.x = pk2(y[0], y[1]); o.y = pk2(y[2], y[3]); o.z = pk2(y[4], y[5]); o.w = pk2(y[6], y[7]); *(v4u*)(orow + c0) = o; }
}
struct Args { const float* in[20]; float* out; unsigned char* ws; };
__global__ void __launch_bounds__(512, 2) fwd_megakernel(Args a) {
    extern __shared__ __attribute__((aligned(16))) unsigned char lds[];
    cg::grid_group grid = cg::this_grid();
    const int tid = threadIdx.x, lane = tid & 63, wave = __builtin_amdgcn_readfirstlane(tid >> 6), G = gridDim.x, bx = blockIdx.x;
    const int gw = bx * 8 + wave, NGW = G * 8;
    unsigned char* ws = a.ws;
    const float *x = a.in[0], *cvec = a.in[1], *ctx = a.in[2], *c_ctx = a.in[3], *w_ada = a.in[4], *b_ada = a.in[5], *g_attn = a.in[6], *g_ffn = a.in[7], *w_in = a.in[8],
                *dec_f = a.in[9], *dec_b = a.in[10], *g_ret = a.in[11], *g_q = a.in[12], *w_uq = a.in[13], *g_kv = a.in[14], *w_ukv = a.in[15], *w_out = a.in[16], *w_ff1 = a.in[17], *w_ff2 = a.in[18], *g_final = a.in[19];
    float* mod = (float*)(ws + WS_MOD); float* rope = (float*)(ws + WS_ROPE); float* ssq = (float*)(ws + WS_SSQ);
    bf16r *WinT = (bf16r*)(ws + WS_WIN), *WuqT = (bf16r*)(ws + WS_WUQ), *WukvT = (bf16r*)(ws + WS_WUKV), *WoutT = (bf16r*)(ws + WS_WOUT), *W1T = (bf16r*)(ws + WS_W1), *W2T = (bf16r*)(ws + WS_W2);
    bf16r *HN = (bf16r*)(ws + WS_HN), *P = (bf16r*)(ws + WS_P), *Q = (bf16r*)(ws + WS_Q), *KV = (bf16r*)(ws + WS_KV), *ST = (bf16r*)(ws + WS_ST), *HID = (bf16r*)(ws + WS_HID);
    bf16r *Y = HN, *H2 = HN, *XOB = HN, *XMB = (bf16r*)(ws + WS_XMB);
    PG8_LAS unsigned char* ldsl = (PG8_LAS unsigned char*)lds;
    volatile LAS unsigned* xst = (volatile LAS unsigned*)((LAS unsigned char*)lds + LDS_BYTES - 64);
    if (tid < 16) xst[tid] = 0u;
    __syncthreads();
    const XcdBarrier xbar = xcd_barrier_post((unsigned*)(ws + WS_CTL), xst);

#if !defined(NO_P0)
    for (int rep_ = 0; rep_ < PROBE_P0_REP; ++rep_) {
    if (bx < 96) {
        int tid = threadIdx.x, lane = tid & 63; LAUNDER_V(tid); LAUNDER_V(lane);
        float* sl = (float*)lds; float* red = (float*)(lds + 17 * 1024 * 4);
        for (int idx = tid; idx < 17 * 1024; idx += 512) { const int r = idx >> 10, k = idx & 1023; const float cv = r < 16 ? cvec[r * 1024 + k] : c_ctx[k]; sl[idx] = cv / (1.f + __expf(-cv)); }
        __syncthreads();
        const int n0 = bx * 64; float acc[17];
#pragma unroll
        for (int r = 0; r < 17; ++r) acc[r] = 0.f;
        for (int kk = 0; kk < 128; kk += 4) { const int k = wave * 128 + kk; const float* wp = w_ada + (size_t)k * 6144 + n0 + lane;
            const float w0 = wp[0], w1 = wp[6144], w2 = wp[2 * 6144], w3 = wp[3 * 6144];
#pragma unroll
            for (int r = 0; r < 17; ++r) { const f32x4 sv = *(const f32x4*)(sl + r * 1024 + k); acc[r] += (sv[0] * w0 + sv[1] * w1) + (sv[2] * w2 + sv[3] * w3); } }
#pragma unroll
        for (int r = 0; r < 17; ++r) red[(wave * 17 + r) * 64 + lane] = acc[r];
        __syncthreads();
        for (int idx = tid; idx < 17 * 64; idx += 512) { const int r = idx >> 6, l = idx & 63; float s = b_ada[n0 + l];
#pragma unroll
            for (int w = 0; w < 8; ++w) s += red[(w * 17 + r) * 64 + l];
            mod[r * 6144 + n0 + l] = s; }
        __syncthreads();
    }
    {
        int tid = threadIdx.x, lane = tid & 63; LAUNDER_V(tid); LAUNDER_V(lane);
        float* scr = (float*)(lds + wave * 16384);
        constexpr int I_IN = (DM / 64) * (NIN / 32), I_UQ = (QL / 64) * (NQ / 32), I_UKV = (KVL / 64) * (NKV / 32), I_OUT = (DM / 64) * (DM / 32), I_1 = (DM / 64) * (DFF / 32), I_2 = (DFF / 64) * (DM / 32);
        constexpr int NITEMS = I_IN + I_UQ + I_UKV + I_OUT + I_1 + I_2;
        for (int it = gw; it < NITEMS; it += NGW) {
            int r = it;
            if (r < I_IN) { transpose_item<1>(w_in, DM, NIN, WinT, nullptr, scr, r, lane); continue; } r -= I_IN;
            if (r < I_UQ) { transpose_item<2>(w_uq, QL, NQ, WuqT, g_q, scr, r, lane); continue; } r -= I_UQ;
            if (r < I_UKV) { transpose_item<0>(w_ukv, KVL, NKV, WukvT, g_kv, scr, r, lane); continue; } r -= I_UKV;
            if (r < I_OUT) { transpose_item<0>(w_out, DM, DM, WoutT, nullptr, scr, r, lane); continue; } r -= I_OUT;
            if (r < I_1) { transpose_item<0>(w_ff1, DM, DFF, W1T, nullptr, scr, r, lane); continue; } r -= I_1;
            transpose_item<0>(w_ff2, DFF, DM, W2T, nullptr, scr, r, lane);
        }
        for (int i = bx * 512 + tid; i < 64 * DM / 8; i += G * 512) ((v4u*)(WinT + (size_t)NIN * DM))[i] = (v4u){0u, 0u, 0u, 0u};
        for (int i = bx * 512 + tid; i < SEQ * 32; i += G * 512) { const int t = i >> 5, j = i & 31; const float pos = (float)(j < 16 ? (t >> 6) : (t & 63));
            const float freq = powf(10000.f, -(float)(j & 15) / 16.f); const float ang = pos * freq; rope[2 * i] = cosf(ang); rope[2 * i + 1] = sinf(ang); }
    }
    }
#endif
    grid.sync();
    for (int rep_ = 0; rep_ < PROBE_P1_REP; ++rep_)
    { int gw1 = gw, ln = lane; LAUNDER_S(gw1); LAUNDER_V(ln);
    for (int row = gw1; row < MALL; row += NGW) { const int b = row / TOK, j = row % TOK;
        const float* src = j < CTXL ? ctx + ((size_t)b * CTXL + j) * DM : x + ((size_t)b * SEQ + (j - CTXL)) * DM; const float* md = mod + (size_t)(j < CTXL ? 16 : b) * 6144;
        norm_mod_row(src, g_attn, md, md + 1024, HN + (size_t)row * DM, ln); } }
    GSYNC();
#if !defined(NO_GEMM)
    for (int rep_ = 0; rep_ < PROBE_P2_REP; ++rep_)
    { pg8::Gemm g{HN, WinT, MALL, NINP, DM, DM}; pg8::InProjOrder S; S.init(G, bx);
      pg8::EpiInProj E{P, ssq, rope};
      pg8::gemm_phase<pg8::EpiInProj, pg8::InProjOrder, true, true>(ldsl, g, S, E); }
#endif
    GSYNC();
#if !defined(NO_R1)
    for (int rep = 0; rep < PROBE_R1_REP; ++rep)
    if (bx < 128) att::ret_states(bx, (const att::bf16*)P, (att::bf16*)ST, dec_f, dec_b, (char*)lds);
#endif
#if !defined(NO_GUQ)
    for (int rep_ = 0; rep_ < PROBE_P3G_REP; ++rep_) {
    { pg8::Gemm g{P + C_CQ, WuqT, MALL, NQ, QL, NINP}; pg8::StaticOrder S; S.init(MALL, NQ, G, bx);
      pg8::EpiUpQ E{Q};
      pg8::gemm_phase<pg8::EpiUpQ, pg8::StaticOrder, true, true>(ldsl, g, S, E); }
#endif
#if !defined(NO_GUKV)
    { pg8::Gemm g{P + C_CKV, WukvT, MALL, NKV, KVL, NINP}; pg8::StaticOrder S; S.init(MALL, NKV, G, bx);
      pg8::EpiUpKV E{KV, ssq};
      pg8::gemm_phase<pg8::EpiUpKV, pg8::StaticOrder, true, true>(ldsl, g, S, E); }
#endif
    }
    GSYNC();
#if !defined(NO_ATT)
    for (int rep = 0; rep < PROBE_ATT_REP; ++rep)
    for (int u = bx; u < 512; u += G) { const int xcd = u & 7, idx = u >> 3, bh = xcd * 8 + (idx >> 3), qb = idx & 7, b = bh >> 2, h = bh & 3;
        const size_t krow = (size_t)b * TOK;
        att::attn_body((const att::bf16*)Q + (krow + CTXL + qb * 256) * NQ + h * 192, (const att::bf16*)KV + krow * NKV + h * 256, (const att::bf16*)KV + krow * NKV + h * 256 + 128,
                       (const att::bf16*)P + krow * NINP + C_KPE, (att::bf16*)Y + ((size_t)b * SEQ + qb * 256) * DM + 512 + h * 128, rope + (size_t)qb * 256 * 64, ssq + (krow + CTXL + qb * 256) * 24, TOK, (char*)lds); }
#endif
#if !defined(NO_R2)
    for (int rep = 0; rep < PROBE_RET_REP; ++rep)
    for (int u = bx; u < 1024; u += G) { const int xcd = u & 7, idx = u >> 3, bh = xcd * 8 + (idx >> 4), n = idx & 15, b = bh >> 2, h = bh & 3;
        const float l2f = -log1pf(expf(-dec_f[h])) * 1.4426950408889634f, l2b = -log1pf(expf(-dec_b[h])) * 1.4426950408889634f;
        att::ret_chunk(b, h, n, (const att::bf16*)P, (const att::bf16*)ST, g_ret, l2f, l2b, (att::bf16*)Y, (char*)lds); }
#endif
    GSYNC();
#if !defined(NO_GOUT)
    for (int rep_ = 0; rep_ < PROBE_P5_REP; ++rep_)
    { pg8::Gemm g{Y, WoutT, MLAT, DM, DM, DM}; pg8::StaticOrder S; S.init(MLAT, DM, G, bx);
      pg8::EpiGateRes<false> E{x, XMB, mod + 2048};
      pg8::gemm_phase<pg8::EpiGateRes<false>, pg8::StaticOrder, true, true>(ldsl, g, S, E); }
#endif
    GSYNC();
    for (int rep_ = 0; rep_ < PROBE_P6_REP; ++rep_)
    { int gw1 = gw, ln = lane; LAUNDER_S(gw1); LAUNDER_V(ln);
    for (int row = gw1; row < MLAT; row += NGW) { const float* md = mod + (size_t)(row / SEQ) * 6144;
        norm_mod_row_bf(XMB + (size_t)row * DM, g_ffn, md + 3072, md + 4096, H2 + (size_t)row * DM, ln); } }
    GSYNC();
#if !defined(NO_GFF1)
    for (int rep_ = 0; rep_ < PROBE_P7_REP; ++rep_)
    { pg8::Gemm g{H2, W1T, MLAT, DFF, DM, DM}; pg8::StaticOrder S; S.init(MLAT, DFF, G, bx);
      pg8::EpiRelu2 E{HID};
      pg8::gemm_phase<pg8::EpiRelu2, pg8::StaticOrder, true, true>(ldsl, g, S, E); }
#endif
    GSYNC();
#if !defined(NO_GFF2)
    { pg8::Gemm g{HID, W2T, MLAT, DM, DFF, DFF}; pg8::StaticOrder S; S.init(MLAT, DM, G, bx);
      pg8::EpiGateRes<true> E{XMB, XOB, mod + 5120};
      pg8::gemm_phase<pg8::EpiGateRes<true>, pg8::StaticOrder, true, true>(ldsl, g, S, E); }
#endif
    GSYNC();
    { int gw1 = gw, ln = lane; LAUNDER_S(gw1); LAUNDER_V(ln);
    for (int row = gw1; row < MLAT; row += NGW) { const bf16r* xrow = XOB + (size_t)row * DM; float v[2][8]; float s = 0.f;
#pragma unroll
        for (int j = 0; j < 2; ++j) { const v4u w = *(const v4u*)(xrow + 8 * ln + 512 * j);
            v[j][0] = __uint_as_float(w.x << 16); v[j][1] = __uint_as_float(w.x & 0xffff0000u); v[j][2] = __uint_as_float(w.y << 16); v[j][3] = __uint_as_float(w.y & 0xffff0000u);
            v[j][4] = __uint_as_float(w.z << 16); v[j][5] = __uint_as_float(w.z & 0xffff0000u); v[j][6] = __uint_as_float(w.w << 16); v[j][7] = __uint_as_float(w.w & 0xffff0000u);
#pragma unroll
            for (int e = 0; e < 8; ++e) s += v[j][e] * v[j][e]; }
        const float rstd = rsqrtf(wave_sum(s) * (1.f / DM) + EPS);
#pragma unroll
        for (int j = 0; j < 2; ++j) { const int c0 = 8 * ln + 512 * j; float* op = a.out + (size_t)row * DM + c0;
#pragma unroll
            for (int h = 0; h < 2; ++h) { const f32x4 gg = *(const f32x4*)(g_final + c0 + 4 * h);
                *(f32x4*)(op + 4 * h) = (f32x4){v[j][4 * h] * rstd * gg[0], v[j][4 * h + 1] * rstd * gg[1], v[j][4 * h + 2] * rstd * gg[2], v[j][4 * h + 3] * rstd * gg[3]}; } }
    } }
}

extern "C" void kernel_launch(void* const* d_in, const int* in_sizes, int n_in, void* d_out, int out_size, void* d_ws, size_t ws_size, hipStream_t stream) {
    static int grid = 0;
    if (grid == 0) {
        if (n_in != 20 || in_sizes[0] != MLAT * DM || out_size != MLAT * DM || ws_size < WS_END) { fprintf(stderr, "kernel_launch: unexpected shapes / workspace (n_in %d, ws %zu)\n", n_in, ws_size); grid = -1; return; }
        int dev = 0, cus = 0, per_cu = 0;
        (void)hipGetDevice(&dev); (void)hipDeviceGetAttribute(&cus, hipDeviceAttributeMultiprocessorCount, dev);
        if (hipFuncSetAttribute((const void*)fwd_megakernel, hipFuncAttributeMaxDynamicSharedMemorySize, LDS_BYTES) != hipSuccess) { fprintf(stderr, "kernel_launch: hipFuncSetAttribute failed\n"); grid = -1; return; }
        if (hipOccupancyMaxActiveBlocksPerMultiprocessor(&per_cu, (const void*)fwd_megakernel, 512, LDS_BYTES) != hipSuccess || per_cu < 1) { fprintf(stderr, "kernel_launch: occupancy query says %d\n", per_cu); grid = -1; return; }
        grid = cus;
    }
    if (grid < 0) return;
    if (hipMemsetAsync((char*)d_ws + WS_CTL, 0, CTL_BYTES, stream) != hipSuccess) { fprintf(stderr, "kernel_launch: memset failed\n"); return; }
    Args a{};
    for (int i = 0; i < 20; ++i) a.in[i] = (const float*)d_in[i];
    a.out = (float*)d_out; a.ws = (unsigned char*)d_ws;
    void* args[] = {&a};
    hipError_t e = hipLaunchCooperativeKernel((const void*)fwd_megakernel, dim3(grid), dim3(512), args, LDS_BYTES, stream);
    if (e != hipSuccess) fprintf(stderr, "cooperative launch failed: %s (grid %d)\n", hipGetErrorString(e), grid);
}
```
